# Optimizing an MI355X kernel written in HIP

```python
import math
import jax
import jax.numpy as jnp
from jax import lax
import numpy as np

D_MODEL = 1024
BATCH = 4
SEQ = 8192
DEPTH = 4

HEAD_DIM = 64
NSA_HEADS = 8
NSA_GROUPS = 2
CMP_LEN = 32
CMP_STRIDE = 16
CMP_HIDDEN = 256
SEL_BLOCK = 64
SEL_TOP_N = 16
NSA_WINDOW = 512
NSA_Q_BLOCK = 64
SWA_HEADS = 8
SWA_KV_HEADS = 2
SWA_WINDOW = 128
SWA_Q_BLOCK = 128
REL_BUCKETS = 32
REL_MAX_DIST = 128
N_HEADS_TOTAL = NSA_HEADS + SWA_HEADS
N_EXPERTS = 32
TOP_K = 4
D_EXPERT = 1024
SWIGLU_ALPHA = 1.702
SWIGLU_LIMIT = 7.0
MOE_BLOCK = 256
RMS_EPS = 1e-5

NSA_Q_W = NSA_HEADS * HEAD_DIM
NSA_KV_W = NSA_GROUPS * HEAD_DIM
SWA_Q_W = SWA_HEADS * HEAD_DIM
SWA_KV_W = SWA_KV_HEADS * HEAD_DIM
IN_SPLITS = (NSA_Q_W, 6 * NSA_KV_W, 3 * NSA_HEADS, SWA_Q_W, 2 * SWA_KV_W, 2 * D_MODEL)
D_IN = NSA_Q_W + 6 * NSA_KV_W + 3 * NSA_HEADS + SWA_Q_W + 2 * SWA_KV_W + 2 * D_MODEL

kernel_name = 'hybrid_nsa_swa_sink_moe_adaln'


def rms_norm(x, g):
    xf = x.astype(jnp.float32)
    y = xf * lax.rsqrt(jnp.mean(xf * xf, axis=-1, keepdims=True) + RMS_EPS)
    return (y * g.astype(jnp.float32)).astype(x.dtype)


def masked_softmax(s, mask):
    s = jnp.where(mask, s.astype(jnp.float32), -jnp.inf)
    m = jnp.max(s, axis=-1, keepdims=True)
    m = jnp.where(jnp.isfinite(m), m, 0.0)
    e = jnp.exp(s - m)
    d = jnp.sum(e, axis=-1, keepdims=True)
    return e / jnp.where(d > 0, d, 1.0)


def t5_bucket(dist):
    n = jnp.maximum(dist, 0)
    max_exact = REL_BUCKETS // 2
    log_ratio = jnp.log(jnp.maximum(n, 1).astype(jnp.float32) / max_exact) / math.log(REL_MAX_DIST / max_exact)
    large = max_exact + (log_ratio * (REL_BUCKETS - max_exact)).astype(jnp.int32)
    return jnp.where(n < max_exact, n, jnp.minimum(large, REL_BUCKETS - 1))


def compress(kv, pos, w1, w2):
    B, S, G, dh = kv.shape
    c = CMP_LEN // CMP_STRIDE
    n_chunks = S // CMP_STRIDE
    n_cmp = n_chunks - c + 1
    ch = kv.reshape(B, n_chunks, CMP_STRIDE, G, dh)
    blocks = jnp.concatenate([ch[:, r:r + n_cmp] for r in range(c)], axis=2)
    blocks = blocks + pos[:, None, :]
    flat = jnp.swapaxes(blocks, 2, 3).reshape(B, n_cmp, G, CMP_LEN * dh)
    return jax.nn.gelu(flat @ w1) @ w2


def nsa_attention(q, k_cmp, v_cmp, k_slc, v_slc, k_win, v_win, branch_gate, rel_tab):
    B, S, G, Hg, dh = q.shape
    n_cmp = k_cmp.shape[1]
    n_blk = S // SEL_BLOCK
    n_sel = min(SEL_TOP_N, n_blk)
    r = SEL_BLOCK // CMP_STRIDE
    c = CMP_LEN // CMP_STRIDE
    pad_front = r + c - 2
    scale = HEAD_DIM ** -0.5
    cmp_end = jnp.arange(n_cmp) * CMP_STRIDE + CMP_LEN - 1
    kb = k_slc.reshape(B, n_blk, SEL_BLOCK, G, dh).transpose(0, 3, 1, 2, 4)
    vb = v_slc.reshape(B, n_blk, SEL_BLOCK, G, dh).transpose(0, 3, 1, 2, 4)
    kw = jnp.pad(k_win, ((0, 0), (NSA_WINDOW, 0), (0, 0), (0, 0)))
    vw = jnp.pad(v_win, ((0, 0), (NSA_WINDOW, 0), (0, 0), (0, 0)))
    tab_g = rel_tab.transpose(1, 0, 2)
    bi = jnp.arange(B)[:, None, None, None]
    gi = jnp.arange(G)[None, None, :, None]
    blk_ids = jnp.arange(n_blk)
    n_win = NSA_WINDOW + NSA_Q_BLOCK

    def block(s0):
        t = s0 + jnp.arange(NSA_Q_BLOCK)
        qb = lax.dynamic_slice_in_dim(q, s0, NSA_Q_BLOCK, axis=1)
        s_c = jnp.einsum('bqghd,bngd->bqghn', qb, k_cmp) * scale
        p_c = masked_softmax(s_c, (cmp_end[None, :] <= t[:, None])[None, :, None, None, :])
        o_c = jnp.einsum('bqghn,bngd->bqghd', p_c.astype(v_cmp.dtype), v_cmp)
        imp = jnp.pad(jnp.sum(p_c, axis=3), ((0, 0), (0, 0), (0, 0), (pad_front, r)))
        p_slc = sum(imp[..., pad_front - m - n: pad_front - m - n + r * n_blk: r]
                    for m in range(r) for n in range(c))
        blk_t = (t // SEL_BLOCK)[:, None]
        future = blk_ids[None, :] > blk_t
        forced = (blk_ids[None, :] == 0) | (blk_ids[None, :] == blk_t) | (blk_ids[None, :] == blk_t - 1)
        score = jnp.where(future[None, :, None, :], -jnp.inf,
                          jnp.where(forced[None, :, None, :], jnp.inf, p_slc))
        _, idx = lax.top_k(score, n_sel)
        ks = kb[bi, gi, idx]
        vs = vb[bi, gi, idx]
        kpos = idx[..., None] * SEL_BLOCK + jnp.arange(SEL_BLOCK)
        dist = t[None, :, None, None, None] - kpos
        bias = tab_g[gi[..., None], t5_bucket(dist)]
        s_s = jnp.einsum('bqghd,bqgnkd->bqghnk', qb, ks) * scale + jnp.moveaxis(bias, -1, 3)
        s_s = s_s.reshape(B, NSA_Q_BLOCK, G, Hg, n_sel * SEL_BLOCK)
        m_s = (dist >= 0).reshape(B, NSA_Q_BLOCK, G, 1, n_sel * SEL_BLOCK)
        p_s = masked_softmax(s_s, m_s)
        o_s = jnp.einsum('bqghm,bqgmd->bqghd', p_s.astype(vs.dtype),
                         vs.reshape(B, NSA_Q_BLOCK, G, n_sel * SEL_BLOCK, dh))
        kwb = lax.dynamic_slice_in_dim(kw, s0, n_win, axis=1)
        vwb = lax.dynamic_slice_in_dim(vw, s0, n_win, axis=1)
        kpos_w = s0 - NSA_WINDOW + jnp.arange(n_win)
        dist_w = t[:, None] - kpos_w[None, :]
        mask_w = (kpos_w[None, :] >= 0) & (dist_w >= 0) & (dist_w < NSA_WINDOW)
        bias_w = rel_tab[t5_bucket(dist_w)].transpose(0, 2, 3, 1)
        s_w = jnp.einsum('bqghd,bkgd->bqghk', qb, kwb) * scale + bias_w[None]
        p_w = masked_softmax(s_w, mask_w[None, :, None, None, :])
        o_w = jnp.einsum('bqghk,bkgd->bqghd', p_w.astype(vwb.dtype), vwb)
        return jnp.stack([o_c, o_s, o_w], axis=2)

    starts = jnp.arange(S // NSA_Q_BLOCK, dtype=jnp.int32) * NSA_Q_BLOCK
    o = lax.map(block, starts)
    o = jnp.moveaxis(o, 0, 1).reshape(B, S, 3, G, Hg, dh)
    o = jnp.sum(branch_gate[..., None] * o, axis=2)
    return o.reshape(B, S, G * Hg * dh)


def swa_attention(q, k, v, sinks, rel_tab):
    B, S, KV, Hg, dh = q.shape
    scale = HEAD_DIM ** -0.5
    n_keys = SWA_WINDOW + SWA_Q_BLOCK
    kp = jnp.pad(k, ((0, 0), (SWA_WINDOW, 0), (0, 0), (0, 0)))
    vp = jnp.pad(v, ((0, 0), (SWA_WINDOW, 0), (0, 0), (0, 0)))

    def block(s0):
        t = s0 + jnp.arange(SWA_Q_BLOCK)
        qb = lax.dynamic_slice_in_dim(q, s0, SWA_Q_BLOCK, axis=1)
        kb = lax.dynamic_slice_in_dim(kp, s0, n_keys, axis=1)
        vb = lax.dynamic_slice_in_dim(vp, s0, n_keys, axis=1)
        kpos = s0 - SWA_WINDOW + jnp.arange(n_keys)
        dist = t[:, None] - kpos[None, :]
        mask = (kpos[None, :] >= 0) & (dist >= 0) & (dist < SWA_WINDOW)
        bias = rel_tab[t5_bucket(dist)].transpose(0, 2, 3, 1)
        s = jnp.einsum('bqghd,bkgd->bqghk', qb, kb) * scale + bias[None]
        sink_col = jnp.broadcast_to(sinks[None, None, :, :, None].astype(s.dtype), s.shape[:-1] + (1,))
        s = jnp.concatenate([s, sink_col], axis=-1)
        mask = jnp.concatenate([mask[None, :, None, None, :],
                                jnp.ones((1, SWA_Q_BLOCK, 1, 1, 1), dtype=bool)], axis=-1)
        p = masked_softmax(s, mask)[..., :-1]
        return jnp.einsum('bqghk,bkgd->bqghd', p.astype(vb.dtype), vb)

    starts = jnp.arange(S // SWA_Q_BLOCK, dtype=jnp.int32) * SWA_Q_BLOCK
    o = lax.map(block, starts)
    return jnp.moveaxis(o, 0, 1).reshape(B, S, KV * Hg * dh)


def clamped_swiglu(gu):
    x_glu, x_lin = gu[..., ::2], gu[..., 1::2]
    x_glu = jnp.minimum(x_glu, SWIGLU_LIMIT)
    x_lin = jnp.clip(x_lin, -SWIGLU_LIMIT, SWIGLU_LIMIT)
    return x_glu * jax.nn.sigmoid(SWIGLU_ALPHA * x_glu) * (x_lin + 1.0)


def moe_ffn(h, w_router, b_router, w_up, b_up, w_down, b_down):
    B, S, D = h.shape
    T = B * S
    E = w_up.shape[0]
    ht = h.reshape(T, D)
    logits = (ht @ w_router + b_router).astype(jnp.float32)
    top_val, top_idx = lax.top_k(logits, TOP_K)
    gate = jax.nn.softmax(top_val, axis=-1)
    A = T * TOP_K
    e_flat = top_idx.reshape(A)
    order = jnp.argsort(e_flat)
    e_sorted = e_flat[order]
    tok_sorted = (order // TOP_K).astype(jnp.int32)
    gate_sorted = gate.reshape(A)[order].astype(h.dtype)
    counts = jnp.zeros((E,), jnp.int32).at[e_flat].add(1)
    starts = jnp.cumsum(counts) - counts
    padded = (counts + MOE_BLOCK - 1) // MOE_BLOCK * MOE_BLOCK
    pad_end = jnp.cumsum(padded)
    dest = pad_end[e_sorted] - padded[e_sorted] + jnp.arange(A, dtype=jnp.int32) - starts[e_sorted]
    n_blocks = -(-A // MOE_BLOCK) + E
    slot_tok = jnp.zeros((n_blocks * MOE_BLOCK,), jnp.int32).at[dest].set(tok_sorted)
    slot_gate = jnp.zeros((n_blocks * MOE_BLOCK,), h.dtype).at[dest].set(gate_sorted)
    block_expert = jnp.minimum(
        jnp.searchsorted(pad_end, jnp.arange(n_blocks, dtype=jnp.int32) * MOE_BLOCK, side='right'),
        E - 1).astype(jnp.int32)

    def body(y, blk):
        tok, g, e = blk
        xb = ht[tok]
        hid = clamped_swiglu(xb @ w_up[e] + b_up[e])
        out = hid @ w_down[e] + b_down[e]
        return y.at[tok].add(out * g[:, None]), None

    y, _ = lax.scan(body, jnp.zeros_like(ht),
                    (slot_tok.reshape(n_blocks, MOE_BLOCK), slot_gate.reshape(n_blocks, MOE_BLOCK), block_expert))
    return y.reshape(B, S, D)


def setup_inputs(seed: int = 0) -> dict:
    key = jax.random.key(seed)
    ks = jax.random.split(key, 24)
    f32 = jnp.float32

    def nrm(k, shape, scale):
        return jax.random.normal(k, shape, f32) * scale

    L = DEPTH
    E = N_EXPERTS
    return {
        'x': nrm(ks[0], (BATCH, SEQ, D_MODEL), 1.0),
        'c': nrm(ks[1], (BATCH, D_MODEL), 1.0),
        'w_ada': nrm(ks[2], (L, D_MODEL, 6 * D_MODEL), 0.5 * D_MODEL ** -0.5),
        'b_ada': nrm(ks[3], (L, 6 * D_MODEL), 0.02),
        'g_mix': 1.0 + nrm(ks[4], (L, D_MODEL), 0.05),
        'g_ffn': 1.0 + nrm(ks[5], (L, D_MODEL), 0.05),
        'g_final': 1.0 + nrm(ks[6], (D_MODEL,), 0.05),
        'w_in': nrm(ks[7], (L, D_MODEL, D_IN), D_MODEL ** -0.5),
        'cmp_pos': nrm(ks[8], (L, 2, CMP_LEN, HEAD_DIM), 0.1),
        'cmp_w1': nrm(ks[9], (L, 2, CMP_LEN * HEAD_DIM, CMP_HIDDEN), (CMP_LEN * HEAD_DIM) ** -0.5),
        'cmp_w2': nrm(ks[10], (L, 2, CMP_HIDDEN, HEAD_DIM), CMP_HIDDEN ** -0.5),
        'sinks': nrm(ks[11], (L, SWA_HEADS), 0.5),
        'rel_tab': nrm(ks[12], (REL_BUCKETS, N_HEADS_TOTAL), 0.2),
        'w_branch': nrm(ks[13], (L, 2, NSA_Q_W, D_MODEL), NSA_Q_W ** -0.5),
        'w_out': nrm(ks[14], (L, D_MODEL, D_MODEL), D_MODEL ** -0.5),
        'w_router': nrm(ks[15], (L, D_MODEL, E), D_MODEL ** -0.5),
        'b_router': nrm(ks[16], (L, E), 0.01),
        'w_up': nrm(ks[17], (L, E, D_MODEL, 2 * D_EXPERT), D_MODEL ** -0.5),
        'b_up': nrm(ks[18], (L, E, 2 * D_EXPERT), 0.01),
        'w_down': nrm(ks[19], (L, E, D_EXPERT, D_MODEL), D_EXPERT ** -0.5),
        'b_down': nrm(ks[20], (L, E, D_MODEL), 0.01),
    }


def reference(x, c, w_ada, b_ada, g_mix, g_ffn, g_final, w_in, cmp_pos, cmp_w1, cmp_w2, sinks, rel_tab,
              w_branch, w_out, w_router, b_router, w_up, b_up, w_down, b_down):
    B, S, D = x.shape
    G, Hg = NSA_GROUPS, NSA_HEADS // NSA_GROUPS
    KV, Hs = SWA_KV_HEADS, SWA_HEADS // SWA_KV_HEADS
    nsa_tab = rel_tab[:, :NSA_HEADS].reshape(REL_BUCKETS, G, Hg)
    swa_tab = rel_tab[:, NSA_HEADS:].reshape(REL_BUCKETS, KV, Hs)
    cond = jax.nn.silu(c)
    offs = [int(v) for v in np.cumsum(IN_SPLITS)[:-1]]
    for l in range(DEPTH):
        mod = (cond @ w_ada[l] + b_ada[l])[:, None, :]
        sh1, sc1, ga1, sh2, sc2, ga2 = jnp.split(mod, 6, axis=-1)
        h = rms_norm(x, g_mix[l]) * (1.0 + sc1) + sh1
        z = h @ w_in[l]
        q_n, kv_n, gate_n, q_s, kv_s, gate_m = jnp.split(z, offs, axis=-1)
        k_c, v_c, k_sl, v_sl, k_w, v_w = [a.reshape(B, S, G, HEAD_DIM) for a in jnp.split(kv_n, 6, axis=-1)]
        k_c = compress(k_c, cmp_pos[l, 0], cmp_w1[l, 0], cmp_w2[l, 0])
        v_c = compress(v_c, cmp_pos[l, 1], cmp_w1[l, 1], cmp_w2[l, 1])
        o_n = nsa_attention(q_n.reshape(B, S, G, Hg, HEAD_DIM), k_c, v_c, k_sl, v_sl, k_w, v_w,
                            jax.nn.sigmoid(gate_n).reshape(B, S, 3, G, Hg), nsa_tab)
        k_s, v_s = jnp.split(kv_s, 2, axis=-1)
        o_s = swa_attention(q_s.reshape(B, S, KV, Hs, HEAD_DIM), k_s.reshape(B, S, KV, HEAD_DIM),
                            v_s.reshape(B, S, KV, HEAD_DIM), sinks[l].reshape(KV, Hs), swa_tab)
        g_a, g_b = jnp.split(jax.nn.sigmoid(gate_m), 2, axis=-1)
        merged = g_a * (o_n @ w_branch[l, 0]) + g_b * (o_s @ w_branch[l, 1])
        x = x + ga1 * (merged @ w_out[l])
        h = rms_norm(x, g_ffn[l]) * (1.0 + sc2) + sh2
        x = x + ga2 * moe_ffn(h, w_router[l], b_router[l], w_up[l], b_up[l], w_down[l], b_down[l])
    return rms_norm(x, g_final)
```

```cpp
#include <hip/hip_runtime.h>
#include <cstdio>
#include <cstdint>

#ifndef MK_PER_PHASE
#define MK_PER_PHASE 0
#endif

#ifndef MOE_FP8_UP
#define MOE_FP8_UP 1
#endif
#ifndef MOE_FP8_DN
#define MOE_FP8_DN 1
#endif
#ifndef Z_FP8
#define Z_FP8 1
#endif
#ifndef MIX_FP8
#define MIX_FP8 1
#endif
#define GM_U8 1
#define EO_FP8 1
#define BG_CONV (MOE_FP8_UP && MOE_FP8_DN)
#ifndef RES_BF16
#define RES_BF16 1
#endif
#define GAS __attribute__((address_space(1)))
#define LAS __attribute__((address_space(3)))
typedef unsigned short bf16;
typedef unsigned v4u __attribute__((ext_vector_type(4)));
typedef unsigned v2u __attribute__((ext_vector_type(2)));
typedef float f32x4 __attribute__((ext_vector_type(4)));
typedef float f32x2 __attribute__((ext_vector_type(2)));
typedef short bf16x8 __attribute__((ext_vector_type(8)));
typedef __bf16 bf16v2 __attribute__((ext_vector_type(2)));
typedef int v4i __attribute__((ext_vector_type(4)));
typedef int v8i __attribute__((ext_vector_type(8)));

constexpr int NB = 4, S = 8192, T = NB * S, D = 1024, NL = 4, NE = 32, TOPK = 4;
constexpr int DIN = 4120, NZ = 4352;
constexpr int NCMP = 511, NCMPP = 512;
constexpr int APAD = T * TOPK + NE * 256;
constexpr float RMS_EPS = 1e-5f;

constexpr size_t MiB = 1u << 20;
constexpr size_t al(size_t x) { return (x + MiB - 1) & ~(MiB - 1); }
constexpr size_t WS_CTL = 0, CTL_BYTES = 1 * MiB;
constexpr size_t WS_MOD = WS_CTL + CTL_BYTES;
constexpr size_t WS_POSB = WS_MOD + al((size_t)NL * NB * 6144 * 4);
constexpr size_t WS_WIN = WS_POSB + MiB;
constexpr size_t WS_WBR = WS_WIN + al((size_t)NL * NZ * 1024 * 2);
constexpr size_t WS_WOUT = WS_WBR + al((size_t)NL * 2 * 1024 * 512 * 2);
constexpr size_t WS_WC1 = WS_WOUT + al((size_t)NL * 1024 * 1024 * 2);
constexpr size_t WS_WUP = WS_WC1 + al((size_t)NL * 2 * 512 * 1024 * 2);
constexpr size_t WS_WDN = WS_WUP + al((size_t)NL * NE * 2048 * 1024 * 2);
constexpr size_t WS_XA = WS_WDN + al((size_t)NL * NE * 1024 * 1024 * 2);
constexpr size_t WS_XB = WS_XA + al((size_t)T * D * 4);
constexpr size_t WS_H = WS_XB + al((size_t)T * D * 4);
constexpr size_t WS_QN = WS_H + al((size_t)T * D * 2);
constexpr size_t WS_QS = WS_QN + al((size_t)T * 512 * 2);
constexpr size_t KVB = (size_t)NB * 2 * S * 64;
constexpr size_t WS_KV = WS_QS + al((size_t)T * 512 * 2);
constexpr size_t WS_GM = WS_KV + al(8 * KVB * 2);
constexpr size_t WS_GN = WS_GM + al((size_t)T * 2048 * 2);
constexpr size_t WS_UL = WS_GN + al((size_t)T * 32 * 2);
constexpr size_t WS_CMP = WS_UL + al((size_t)8192 * 512 * 4);
constexpr size_t WS_ON = WS_CMP + al((size_t)2 * NB * 2 * 512 * 64 * 2);
constexpr size_t WS_OS = WS_ON + al((size_t)T * 512 * 2);
constexpr size_t WS_MG = WS_OS + al((size_t)T * 512 * 2);
constexpr size_t WS_MG2 = WS_MG + al((size_t)T * 1024 * 2);
constexpr size_t WS_TOPI = WS_MG2 + al((size_t)T * 1024 * 2);
constexpr size_t WS_GW = WS_TOPI + al((size_t)T * 4 * 4);
constexpr size_t WS_LIST = WS_GW + al((size_t)T * 4 * 4);
constexpr size_t WS_HID = WS_LIST + al((size_t)NE * T * 4);
constexpr size_t WS_EO = WS_HID + al((size_t)APAD * 1024 * 2);
constexpr size_t WS_H8 = WS_EO + al((size_t)APAD * 1024 * 2);
constexpr size_t WS_END = WS_H8 + al((size_t)T * D);
constexpr int CW_TMO = 0;
constexpr int CW_BAR = 4096;
constexpr int CW_CNT = 16384;

constexpr int RING_BYTES = 131072;
constexpr int MISC_OFF = RING_BYTES;
constexpr int LDS_BYTES = 147456;
constexpr int NWAVES = 8, NTHR = 512;

#define RLX_AGENT __ATOMIC_RELAXED, __HIP_MEMORY_SCOPE_AGENT
#define LDS_WAIT() asm volatile("s_waitcnt lgkmcnt(0)" ::: "memory")
#define VM_WAIT() asm volatile("s_waitcnt vmcnt(0)" ::: "memory")
__device__ __forceinline__ unsigned f2bf(float f) { unsigned u = __builtin_bit_cast(unsigned, f); return (u + 0x7fffu + ((u >> 16) & 1u)) >> 16; }
__device__ __forceinline__ unsigned pk2(float lo, float hi) { return f2bf(lo) | (f2bf(hi) << 16); }
__device__ __forceinline__ float bflo(unsigned w) { return __builtin_bit_cast(float, w << 16); }
__device__ __forceinline__ float bfhi(unsigned w) { return __builtin_bit_cast(float, w & 0xffff0000u); }
__device__ __forceinline__ unsigned cvt_pk_bf16(float lo, float hi) { unsigned r; asm volatile("v_cvt_pk_bf16_f32 %0, %1, %2" : "=v"(r) : "v"(lo), "v"(hi)); return r; }
__device__ __forceinline__ unsigned pack_fp8x4_raw(float a, float b, float c, float d) { unsigned w = __builtin_amdgcn_cvt_pk_fp8_f32(a, b, 0, false); return __builtin_amdgcn_cvt_pk_fp8_f32(c, d, w, true); }
__device__ __forceinline__ float sat8(float x) { return __builtin_amdgcn_fmed3f(x, -448.0f, 448.0f); }
__device__ __forceinline__ unsigned pack_fp8x4(float a, float b, float c, float d) { return pack_fp8x4_raw(sat8(a), sat8(b), sat8(c), sat8(d)); }
constexpr float W8_SCALE = 64.0f, H8_SCALE = 4.0f, HID8_SCALE = 4.0f, O8_SCALE = 16.0f, MG8_SCALE = 16.0f;
constexpr float EO8_SCALE = 16.0f;
constexpr int MIX_E8M0 = 0x7a7a7a7a;
constexpr int W8_E8M0 = 0x7b7b7b7b, H8_E8M0 = 0x7b7b7b7b, HID8_E8M0 = 0x7b7b7b7b;
__device__ __forceinline__ float sigmoidf_(float x) { return __builtin_amdgcn_rcpf(1.0f + __expf(-x)); }
__device__ __forceinline__ int dpp_x1i(int x) { return __builtin_amdgcn_update_dpp(0, x, 0xB1, 0xF, 0xF, true); }
__device__ __forceinline__ int dpp_x2i(int x) { return __builtin_amdgcn_update_dpp(0, x, 0x4E, 0xF, 0xF, true); }
__device__ __forceinline__ int dpp_hmi(int x) { return __builtin_amdgcn_update_dpp(0, x, 0x141, 0xF, 0xF, true); }
__device__ __forceinline__ float dpp_x1(float x) { return __builtin_bit_cast(float, dpp_x1i(__builtin_bit_cast(int, x))); }
__device__ __forceinline__ float dpp_x2(float x) { return __builtin_bit_cast(float, dpp_x2i(__builtin_bit_cast(int, x))); }
__device__ __forceinline__ float dpp_hm(float x) { return __builtin_bit_cast(float, dpp_hmi(__builtin_bit_cast(int, x))); }
__device__ __forceinline__ int dpp_rmi(int x) { return __builtin_amdgcn_update_dpp(0, x, 0x140, 0xF, 0xF, true); }
__device__ __forceinline__ float dpp_rm(float x) { return __builtin_bit_cast(float, dpp_rmi(__builtin_bit_cast(int, x))); }
__device__ __forceinline__ float quad_sum(float x) { x += dpp_x1(x); return x + dpp_x2(x); }
__device__ __forceinline__ float wave_sum(float v) {
    v += dpp_x1(v); v += dpp_x2(v); v += dpp_hm(v); v += dpp_rm(v);
    v += __shfl_xor(v, 16); v += __shfl_xor(v, 32);
    return v;
}

#define XB_TMO      128
#define XB_XCNT(j)  (256  + 64 * (j))
#define XB_XSUB(j)  (1280 + 64 * (j))
#define XB_XGEN(j)  (2304 + 64 * (j))
#define XB_TOP      3328
#define XB_TOPGEN   3392
#define XCD_BAR_WORDS 3456
#define XB_SPIN_CAP (1u << 22)
__device__ __forceinline__ unsigned xb_ld(unsigned* p)              { return __hip_atomic_load(p, __ATOMIC_RELAXED, __HIP_MEMORY_SCOPE_AGENT); }
__device__ __forceinline__ unsigned xb_add(unsigned* p, unsigned v) { return __hip_atomic_fetch_add(p, v, __ATOMIC_RELAXED, __HIP_MEMORY_SCOPE_AGENT); }
__device__ __forceinline__ unsigned xb_xcc_id() { return (unsigned)__builtin_amdgcn_s_getreg((3 << 11) | 20) & 0xFu; }
#define XB_SPIN(cond, bar) do { unsigned _sp = 0; while (cond) { __builtin_amdgcn_s_sleep(1); \
    if ((++_sp & 255u) == 0u) { if (xb_ld(&(bar)[XB_TMO])) break; if (_sp > XB_SPIN_CAP) { atomicAdd(&(bar)[XB_TMO], 1u); break; } } } } while (0)
struct XcdBarrier { unsigned* bar; unsigned x; volatile LAS unsigned* st; };
__device__ __forceinline__ XcdBarrier xcd_barrier_post(unsigned* bar, volatile LAS unsigned* st) {
    XcdBarrier b; b.bar = bar; b.x = xb_xcc_id(); b.st = st;
    if (threadIdx.x == 0) (void)xb_add(&bar[XB_XCNT(b.x)], 1u);
    return b;
}
__device__ __forceinline__ void xcd_barrier_complete(unsigned* bar, unsigned x, unsigned& nloc, unsigned& nx) {
    const unsigned G = gridDim.x * gridDim.y * gridDim.z;
    unsigned sum, cnt, mine, sp = 0u;
    for (;;) {
        sum = 0u; cnt = 0u; mine = 0u;
#pragma unroll
        for (unsigned j = 0; j < 16; ++j) { const unsigned c = xb_ld(&bar[XB_XCNT(j)]); sum += c; cnt += (c > 0u) ? 1u : 0u; mine = (j == x) ? c : mine; }
        if (sum == G) break;
        __builtin_amdgcn_s_sleep(1);
        if ((++sp & 255u) == 0u) { if (xb_ld(&bar[XB_TMO])) break; if (sp > XB_SPIN_CAP) { atomicAdd(&bar[XB_TMO], 1u); break; } }
    }
    nloc = mine > 0u ? mine : 1u; nx = cnt > 0u ? cnt : 1u;
}
__device__ __forceinline__ void xcd_barrier(const XcdBarrier& b) {
    asm volatile("s_waitcnt vmcnt(0)" ::: "memory");
    __syncthreads();
    if (threadIdx.x == 0) {
        unsigned* bar = b.bar;
        __builtin_amdgcn_s_waitcnt(0);
        unsigned nloc = b.st[0], nx = b.st[1];
        if (nloc == 0u) { xcd_barrier_complete(bar, b.x, nloc, nx); b.st[0] = nloc; b.st[1] = nx; }
        const unsigned old = xb_add(&bar[XB_XSUB(b.x)], 1u);
        const unsigned gen = old / nloc;
        if (old + 1u == (gen + 1u) * nloc) {
            __builtin_amdgcn_fence(__ATOMIC_RELEASE, "agent");
            asm volatile("s_waitcnt vmcnt(0)" ::: "memory");
            const unsigned og = xb_add(&bar[XB_TOP], 1u);
            const unsigned tg = og / nx;
            if (og + 1u == (tg + 1u) * nx) xb_add(&bar[XB_TOPGEN], 1u);
            else XB_SPIN(xb_ld(&bar[XB_TOPGEN]) == tg, bar);
            __builtin_amdgcn_fence(__ATOMIC_ACQUIRE, "agent");
            xb_add(&bar[XB_XGEN(b.x)], 1u);
            asm volatile("s_waitcnt vmcnt(0)" ::: "memory");
        } else {
            XB_SPIN(xb_ld(&bar[XB_XGEN(b.x)]) == gen, bar);
            __builtin_amdgcn_fence(__ATOMIC_ACQUIRE, "agent");
            asm volatile("s_waitcnt vmcnt(0)" ::: "memory");
        }
    }
    __syncthreads();
}

namespace pg8 {
constexpr int BM = 256, BK = 64, HALF = 128, HTB = HALF * BK * 2, STAGE_BYTES = 8 * HTB;
__host__ __device__ __forceinline__ int lds_byte(int r, int c) { const int st = (r >> 4) * 2 + (c >> 5), rr = r & 15, cc = c & 31, ob = rr * 64 + cc * 2; return st * 1024 + (ob ^ (((ob >> 9) & 1) << 5)); }
__host__ __device__ __forceinline__ void stage_rc(int b, int& R, int& C) { const int st = b / 1024, sb = b % 1024, swz = sb ^ (((sb >> 9) & 1) << 5); R = (st >> 1) * 16 + swz / 64; C = (st & 1) * 32 + (swz % 64) / 2; }
__host__ __device__ __forceinline__ int perm32(int rho) { const int n = rho >> 4, i = rho & 15; return 8 * (i >> 2) + 4 * n + (i & 3); }
struct Unit { int pm, pn, e, par; };
template <class Epi, class Sched, bool FP8 = false>
__device__ __forceinline__ void gemm_phase(LAS unsigned char* lds, const int K, const Sched& S, const Epi& E, const int sc_w = 0x7f7f7f7f, const int sc_a = 0x7f7f7f7f) {
    int tid = threadIdx.x; asm volatile("" : "+v"(tid));
    const int wid = __builtin_amdgcn_readfirstlane(tid >> 6), lane = tid & 63, wr = wid >> 2, wc = wid & 3, fr = lane & 15, fq = lane >> 4;
    const int nt = K / BK;
    unsigned voffA[2], voffB[2];
#pragma unroll
    for (int i = 0; i < 2; ++i) { int R, C; stage_rc(tid * 16 + i * 8192, R, C); const int Rb = Epi::PERM ? ((R & ~31) + perm32(R & 31)) : R; voffA[i] = (unsigned)(R * K + C) * 2u; voffB[i] = (unsigned)(Rb * K + C) * 2u; }
    const unsigned kstep = (unsigned)(BK * 2);
    const size_t hstep = (size_t)HALF * K * 2;
    const unsigned ldsw = (unsigned)wid * 1024u;
    const int aoff = lds_byte(wr * 64 + fr, fq * 8), boff = lds_byte(wc * 32 + fr, fq * 8);
#define PG8_SA(b, h) (((b) * 2 + (h)) * HTB)
#define PG8_SB(b, h) ((4 + (b) * 2 + (h)) * HTB)
#define PG8_STAGE_B(bufoff, gbase) do { _Pragma("unroll") for (int _i = 0; _i < 2; ++_i) \
        __builtin_amdgcn_global_load_lds((const unsigned*)((const char*)(gbase) + voffB[_i]), (LAS unsigned*)(lds + (bufoff) + ldsw + _i * 8192), 16, 0, 0); } while (0)
#define PG8_STAGE_A(bufoff, gbase, h, OFFS) do { _Pragma("unroll") for (int _i = 0; _i < 2; ++_i) { const char* _p; \
        if constexpr (Sched::GATHER) _p = (const char*)(gbase) + (OFFS)[h][_i]; else _p = (const char*)(gbase) + (size_t)(h) * hstep + voffA[_i]; \
        __builtin_amdgcn_global_load_lds((const unsigned*)_p, (LAS unsigned*)(lds + (bufoff) + ldsw + _i * 8192), 16, 0, 0); } } while (0)
#define PG8_LD8(p) __builtin_shufflevector(*(const LAS v4i*)(p), *(const LAS v4i*)((p) + 1024), 0, 1, 2, 3, 4, 5, 6, 7)
#define PG8_LDA(dst, b, h) do { _Pragma("unroll") for (int m = 0; m < 4; ++m) { if constexpr (FP8) dst##8[m] = PG8_LD8(lds + PG8_SA(b, h) + aoff + m * 2048); \
        else { _Pragma("unroll") for (int k = 0; k < 2; ++k) dst[m][k] = *(const LAS bf16x8*)(lds + PG8_SA(b, h) + aoff + m * 2048 + k * 1024); } } } while (0)
#define PG8_LDB(dst, b, h) do { _Pragma("unroll") for (int n = 0; n < 2; ++n) { if constexpr (FP8) dst##8[n] = PG8_LD8(lds + PG8_SB(b, h) + boff + n * 2048); \
        else { _Pragma("unroll") for (int k = 0; k < 2; ++k) dst[n][k] = *(const LAS bf16x8*)(lds + PG8_SB(b, h) + boff + n * 2048 + k * 1024); } } } while (0)
#define PG8_MMA(ai, bj, At, Bt) do { __builtin_amdgcn_s_setprio(1); _Pragma("unroll") for (int m = 0; m < 4; ++m) _Pragma("unroll") for (int n = 0; n < 2; ++n) { \
        if constexpr (FP8) acc[ai][bj][m][n] = __builtin_amdgcn_mfma_scale_f32_16x16x128_f8f6f4(Bt##8[n], At##8[m], acc[ai][bj][m][n], 0, 0, 0, sc_w, 0, sc_a); \
        else { _Pragma("unroll") for (int k = 0; k < 2; ++k) acc[ai][bj][m][n] = __builtin_amdgcn_mfma_f32_16x16x32_bf16(Bt[n][k], At[m][k], acc[ai][bj][m][n], 0, 0, 0); } } \
        __builtin_amdgcn_s_setprio(0); } while (0)
#define PG8_WAIT_V(n) asm volatile("s_waitcnt vmcnt(" #n ")" ::: "memory")
#define PG8_WAIT_L(n) asm volatile("s_waitcnt lgkmcnt(" #n ")" ::: "memory")
#define PG8_BAR __builtin_amdgcn_s_barrier()
#define PG8_SCHED __builtin_amdgcn_sched_barrier(0)
    Unit cur, nxt; int ui = 0;
    if (!S.next(0, cur)) return;
    f32x4 acc[2][2][4][2];
#pragma unroll
    for (int a = 0; a < 2; ++a)
#pragma unroll
        for (int b = 0; b < 2; ++b)
#pragma unroll
            for (int m = 0; m < 4; ++m)
#pragma unroll
                for (int n = 0; n < 2; ++n) acc[a][b][m][n] = (f32x4){0.f, 0.f, 0.f, 0.f};
    bf16x8 At[4][2], B0[2][2], B1[2][2]; v8i At8[4], B08[2], B18[2];
    unsigned coff[2][2] = {{0u, 0u}, {0u, 0u}};
    LAS v4u* const noff_slot = (LAS v4u*)(lds + STAGE_BYTES + 1024) + tid;
    if constexpr (Sched::GATHER) S.a_off(cur, coff);
    const char* cA = S.a_ptr(cur);
    const char* cB = S.b_base(cur);
    cur.par = 0;
    if constexpr (Epi::PRE) { if (wid == 0) E.pre(cur, lane); }
    PG8_STAGE_B(PG8_SB(0, 0), cB); PG8_STAGE_B(PG8_SB(0, 1), cB + hstep); PG8_STAGE_A(PG8_SA(0, 0), cA, 0, coff); PG8_STAGE_A(PG8_SA(0, 1), cA, 1, coff);
    if (wr == 1) PG8_BAR;
    PG8_WAIT_V(2); PG8_BAR;
    PG8_STAGE_B(PG8_SB(1, 0), cB + kstep); PG8_STAGE_A(PG8_SA(1, 0), cA + kstep, 0, coff); PG8_STAGE_B(PG8_SB(1, 1), cB + hstep + kstep);
    PG8_WAIT_V(6); PG8_BAR;
    unsigned ptok[2][2] = {{0u, 0u}, {0u, 0u}}; Unit nx2; bool has_n = false;
    if constexpr (Sched::GATHER) { has_n = S.next(1, nxt); if (has_n) S.a_tok(nxt, ptok); }
    for (;;) {
        bool has_next;
        if constexpr (Sched::GATHER) has_next = has_n; else has_next = S.next(ui + 1, nxt);
        const char* nA = cA; const char* nB = cB;
        if (has_next) { nA = S.a_ptr(nxt); nB = S.b_base(nxt); }
        if constexpr (Sched::GATHER) { unsigned tmp[2][2]; if (has_next) S.tok_off(ptok, tmp); else { tmp[0][0] = coff[0][0]; tmp[0][1] = coff[0][1]; tmp[1][0] = coff[1][0]; tmp[1][1] = coff[1][1]; }
            v4u w; w.x = tmp[0][0]; w.y = tmp[0][1]; w.z = tmp[1][0]; w.w = tmp[1][1]; *noff_slot = w;
            has_n = has_next && S.next(ui + 2, nx2); if (has_n) S.a_tok(nx2, ptok); }
#pragma unroll 1
        for (int t = 0; t < nt; t += 2) {
            if constexpr (Epi::MID) { if (t == nt / 2) { int tz = threadIdx.x; asm volatile("" : "+v"(tz)); const int wz = tz >> 6, lz = tz & 63; E.mid(acc, cur, wz >> 2, wz & 3, lz & 15, lz >> 4); } }
            const bool last = (t == nt - 2);
            const char* a1 = cA + (size_t)(t + 1) * kstep;
            const char* a2 = last ? nA : cA + (size_t)(t + 2) * kstep; const char* b2 = last ? nB : cB + (size_t)(t + 2) * kstep;
            const char* a3 = a2 + kstep; const char* b3 = b2 + kstep;
            PG8_LDB(B0, 0, 0); PG8_LDB(B1, 0, 1); PG8_SCHED; PG8_LDA(At, 0, 0); PG8_STAGE_A(PG8_SA(1, 1), a1, 1, coff);
            if constexpr (Sched::GATHER) { if (last) { const v4u w = *noff_slot; coff[0][0] = w.x; coff[0][1] = w.y; coff[1][0] = w.z; coff[1][1] = w.w; } }
            PG8_WAIT_V(8); PG8_WAIT_L(0); PG8_BAR; PG8_MMA(0, 0, At, B0); PG8_MMA(0, 1, At, B1); PG8_BAR; PG8_SCHED;
            PG8_LDA(At, 0, 1); PG8_STAGE_B(PG8_SB(0, 0), b2); PG8_STAGE_B(PG8_SB(0, 1), b2 + hstep); PG8_STAGE_A(PG8_SA(0, 0), a2, 0, coff);
            PG8_WAIT_V(8); PG8_WAIT_L(0); PG8_BAR; PG8_MMA(1, 0, At, B0); PG8_MMA(1, 1, At, B1); PG8_BAR; PG8_SCHED;
            PG8_LDB(B0, 1, 0); PG8_LDB(B1, 1, 1); PG8_SCHED; PG8_LDA(At, 1, 0); PG8_STAGE_A(PG8_SA(0, 1), a2, 1, coff);
            PG8_WAIT_V(8); PG8_WAIT_L(0); PG8_BAR; PG8_MMA(0, 0, At, B0); PG8_MMA(0, 1, At, B1); PG8_BAR; PG8_SCHED;
            PG8_LDA(At, 1, 1); PG8_STAGE_B(PG8_SB(1, 0), b3); PG8_STAGE_B(PG8_SB(1, 1), b3 + hstep); PG8_STAGE_A(PG8_SA(1, 0), a3, 0, coff);
            PG8_WAIT_V(8); PG8_WAIT_L(0); PG8_BAR; PG8_MMA(1, 0, At, B0); PG8_MMA(1, 1, At, B1); PG8_BAR; PG8_SCHED;
        }
        if (wr == 0) PG8_BAR;
        { int tz = threadIdx.x; asm volatile("" : "+v"(tz));
          const int wz = tz >> 6, lz = tz & 63; E(acc, cur, wz >> 2, wz & 3, lz & 15, lz >> 4); }
        if (!has_next) break;
#pragma unroll
        for (int a = 0; a < 2; ++a)
#pragma unroll
            for (int b = 0; b < 2; ++b)
#pragma unroll
                for (int m = 0; m < 4; ++m)
#pragma unroll
                    for (int n = 0; n < 2; ++n) acc[a][b][m][n] = (f32x4){0.f, 0.f, 0.f, 0.f};
        cur = nxt; cur.par = (ui + 1) & 1; cA = nA; cB = nB; ++ui; if constexpr (Sched::GATHER) nxt = nx2;
        if constexpr (Epi::PRE) { if (wid == 0) E.pre(cur, lane); }
        if (wr == 1) PG8_BAR;
    }
    PG8_WAIT_V(0);
    PG8_BAR;
#undef PG8_SA
#undef PG8_SB
#undef PG8_STAGE_A
#undef PG8_STAGE_B
#undef PG8_LDA
#undef PG8_LD8
#undef PG8_LDB
#undef PG8_MMA
#undef PG8_WAIT_V
#undef PG8_WAIT_L
#undef PG8_BAR
#undef PG8_SCHED
}
}
using pg8::Unit;

struct Frame {
    LAS unsigned char* lds;
    volatile LAS unsigned* MISC;
    unsigned* ctl;
    int tid, lane, wave, vcu, G;
    const float *x, *c, *w_ada, *b_ada, *g_mix, *g_ffn, *g_final, *w_in, *cmp_pos, *cmp_w1, *cmp_w2, *sinks, *rel_tab, *w_branch, *w_out, *w_router, *b_router, *w_up, *b_up, *w_down, *b_down;
    float* out; unsigned char* ws;
};
constexpr int MW_TSTART = 16;
constexpr int MW_CNT = 64;
constexpr int MB_BIAS = 13312;
constexpr int MB_TEXP = 12288;

template <bool GATHER_ = false>
struct DenseSched {
    static constexpr bool GATHER = GATHER_;
    const char* A; const char* B; int nN, nU, G, c; unsigned lda2; size_t btile; int bsplit_pm; size_t bsplit_stride;
    __device__ __forceinline__ bool next(int i, Unit& u) const { const int L = i * G + c; if (L >= nU) return false; u.pm = L / nN; u.pn = L - u.pm * nN; u.e = 0; return true; }
    __device__ __forceinline__ const char* a_ptr(const Unit& u) const { return GATHER ? A : A + (size_t)u.pm * 256 * lda2; }
    __device__ __forceinline__ void a_off(const Unit& u, unsigned (&off)[2][2]) const {
        int tz = threadIdx.x; asm volatile("" : "+v"(tz));
#pragma unroll
        for (int i = 0; i < 2; ++i) { int R, C; pg8::stage_rc(tz * 16 + i * 8192, R, C);
#pragma unroll
            for (int h = 0; h < 2; ++h) off[h][i] = (unsigned)(u.pm * 256 + h * 128 + R) * lda2 + (unsigned)C * 2u; } }
    __device__ __forceinline__ void a_tok(const Unit& u, unsigned (&tok)[2][2]) const { tok[0][0] = tok[0][1] = tok[1][0] = tok[1][1] = (unsigned)u.pm; }
    __device__ __forceinline__ void tok_off(const unsigned (&tok)[2][2], unsigned (&off)[2][2]) const { Unit u; u.pm = (int)tok[0][0]; u.pn = 0; u.e = 0; a_off(u, off); }
    __device__ __forceinline__ const char* b_base(const Unit& u) const { return B + (u.pm >= bsplit_pm ? bsplit_stride : (size_t)0) + (size_t)u.pn * btile; }
};
struct MergeSched {
    static constexpr bool GATHER = false;
    const char* A; const char* B; int G, c;
    __device__ __forceinline__ bool next(int i, Unit& u) const { const int L = (i >> 1) * G + c; if (L >= (T / 256) * 4) return false; u.pm = L >> 2; u.pn = L & 3; u.e = i & 1; return true; }
    __device__ __forceinline__ const char* a_ptr(const Unit& u) const { return A + (size_t)u.pm * 256 * 1024 + (u.e ? (size_t)(WS_OS - WS_ON) : (size_t)0); }
    __device__ __forceinline__ void a_off(const Unit&, unsigned (&)[2][2]) const {}
    __device__ __forceinline__ void a_tok(const Unit&, unsigned (&)[2][2]) const {}
    __device__ __forceinline__ void tok_off(const unsigned (&)[2][2], unsigned (&)[2][2]) const {}
    __device__ __forceinline__ const char* b_base(const Unit& u) const { return B + ((size_t)u.e * 1024 + (size_t)u.pn * 256) * 512 * 2; }
};
template <bool GATHER_>
struct MoeSched {
    static constexpr bool GATHER = GATHER_;
    const char* A; const char* B; const int* list; volatile LAS unsigned* M; int nN, G, c; size_t bexp  ; size_t btile; unsigned rowb  ; bool use_list  ;
    __device__ __forceinline__ bool next(int i, Unit& u) const {
        const int L = i * G + c; const int nU = (int)M[MW_TSTART + 32] * nN; if (L >= nU) return false;
        u.pm = L / nN; u.pn = L - u.pm * nN; u.e = (int)((volatile LAS unsigned char*)M)[MB_TEXP + u.pm]; return true; }
    __device__ __forceinline__ const char* a_ptr(const Unit& u) const { return GATHER ? A : A + (size_t)u.pm * 256 * rowb; }
    __device__ __forceinline__ void a_tok(const Unit& u, unsigned (&tok)[2][2]) const {
        int tz = threadIdx.x; asm volatile("" : "+v"(tz));
        const int p0 = (u.pm - (int)M[MW_TSTART + u.e]) * 256, cnt = (int)M[MW_CNT + u.e];
#pragma unroll
        for (int i = 0; i < 2; ++i) { int R, C; pg8::stage_rc(tz * 16 + i * 8192, R, C);
#pragma unroll
            for (int h = 0; h < 2; ++h) { const int p = p0 + h * 128 + R; tok[h][i] = (unsigned)(use_list ? (p < cnt ? list[(size_t)u.e * T + p] : 0) : (u.pm * 256 + h * 128 + R)); } }
    }
    __device__ __forceinline__ void tok_off(const unsigned (&tok)[2][2], unsigned (&off)[2][2]) const {
        int tz = threadIdx.x; asm volatile("" : "+v"(tz));
#pragma unroll
        for (int i = 0; i < 2; ++i) { int R, C; pg8::stage_rc(tz * 16 + i * 8192, R, C);
#pragma unroll
            for (int h = 0; h < 2; ++h) off[h][i] = tok[h][i] * rowb + (unsigned)C * 2u; }
    }
    __device__ __forceinline__ void a_off(const Unit& u, unsigned (&off)[2][2]) const { unsigned tok[2][2]; a_tok(u, tok); tok_off(tok, off); }
    __device__ __forceinline__ const char* b_base(const Unit& u) const { return B + (size_t)u.e * bexp + (size_t)u.pn * btile; }
};

__device__ __forceinline__ unsigned gate_u8x4(float a, float b, float c, float d) {
    const float qa = __builtin_amdgcn_fmed3f(sigmoidf_(a) * 255.0f, 1.0f, 255.0f), qb = __builtin_amdgcn_fmed3f(sigmoidf_(b) * 255.0f, 1.0f, 255.0f), qc = __builtin_amdgcn_fmed3f(sigmoidf_(c) * 255.0f, 1.0f, 255.0f), qd = __builtin_amdgcn_fmed3f(sigmoidf_(d) * 255.0f, 1.0f, 255.0f);
    unsigned w = 0u; w = __builtin_amdgcn_cvt_pk_u8_f32(qa, 0, w); w = __builtin_amdgcn_cvt_pk_u8_f32(qb, 1, w); w = __builtin_amdgcn_cvt_pk_u8_f32(qc, 2, w); w = __builtin_amdgcn_cvt_pk_u8_f32(qd, 3, w); return w; }
__device__ __forceinline__ float ub(unsigned w, int i) { return (float)((w >> (8 * i)) & 0xffu); }
struct EpiZ { static constexpr bool PRE = false, MID = false, PERM = true; unsigned char* ws;
    __device__ __forceinline__ void operator()(const f32x4 (&acc)[2][2][4][2], const Unit& u, int wr, int wc, int fr, int fq) const {
        const int pn = u.pn, tok0 = u.pm * 256, rowl0 = wr * 64 + fr, cw = wc * 32 + 8 * fq;
#pragma unroll
        for (int bj = 0; bj < 2; ++bj) {
            const int c256 = bj * 128 + cw; bf16* base; int ld; bool skip = false;
            if (pn < 2) { base = (bf16*)(ws + WS_QN) + (size_t)tok0 * 512 + pn * 256 + c256; ld = 512; }
            else if (pn < 5 || pn == 7) { const int kvi = (pn == 7 ? 6 : (pn - 2) * 2) + bj, g = cw >> 6, b = tok0 / S, s0 = tok0 % S;
                base = (bf16*)(ws + WS_KV) + ((size_t)(kvi * NB + b) * 2 + g) * S * 64 + (size_t)s0 * 64 + (cw & 63); ld = 64; }
            else if (pn < 7) { base = (bf16*)(ws + WS_QS) + (size_t)tok0 * 512 + (pn - 5) * 256 + c256; ld = 512; }
            else if (pn < 16) { base = (bf16*)(ws + WS_GM) + (size_t)tok0 * 2048 + (pn - 8) * 256 + c256; ld = 2048; }
            else { base = (bf16*)(ws + WS_GN) + (size_t)tok0 * 32 + c256; ld = 32; skip = c256 >= 32; }
            if (!skip) {
#pragma unroll
                for (int ai = 0; ai < 2; ++ai)
#pragma unroll
                    for (int m = 0; m < 4; ++m) { const f32x4 v0 = acc[ai][bj][m][0], v1 = acc[ai][bj][m][1];
                        if (GM_U8 && pn >= 8 && pn < 16) { unsigned char* g8 = ws + WS_GM + (size_t)(tok0 + rowl0 + ai * 128 + m * 16) * 2048 + (pn - 8) * 256 + c256;
                            v2u w; w.x = gate_u8x4(v0[0], v0[1], v0[2], v0[3]); w.y = gate_u8x4(v1[0], v1[1], v1[2], v1[3]); *(v2u*)g8 = w; }
                        else { v4u w; w.x = cvt_pk_bf16(v0[0], v0[1]); w.y = cvt_pk_bf16(v0[2], v0[3]); w.z = cvt_pk_bf16(v1[0], v1[1]); w.w = cvt_pk_bf16(v1[2], v1[3]);
                        *(v4u*)(base + (size_t)(rowl0 + ai * 128 + m * 16) * ld) = w; } }
            }
        }
    }
};
struct EpiF32 { static constexpr bool PRE = false, MID = false, PERM = false; float* C; int ldc;
    __device__ __forceinline__ void operator()(const f32x4 (&acc)[2][2][4][2], const Unit& u, int wr, int wc, int fr, int fq) const {
        const int row0 = u.pm * 256 + wr * 64 + fr, col0 = u.pn * 256 + wc * 32 + 4 * fq;
#pragma unroll
        for (int ai = 0; ai < 2; ++ai)
#pragma unroll
            for (int m = 0; m < 4; ++m) { float* rowp = C + (size_t)(row0 + ai * 128 + m * 16) * ldc + col0;
#pragma unroll
                for (int bj = 0; bj < 2; ++bj)
#pragma unroll
                    for (int n = 0; n < 2; ++n) *(f32x4*)(rowp + bj * 128 + n * 16) = acc[ai][bj][m][n]; }
    }
};
struct EpiMerge { static constexpr bool PRE = false, MID = false, PERM = true; unsigned char* ws;
    __device__ __forceinline__ void operator()(const f32x4 (&acc)[2][2][4][2], const Unit& u, int wr, int wc, int fr, int fq) const {
        const int row0 = u.pm * 256 + wr * 64 + fr, col0 = u.pn * 256 + wc * 32 + 8 * fq, pass = u.e;
        const bf16* GM = (const bf16*)(ws + WS_GM) + pass * 1024; bf16* MG2 = (bf16*)(ws + WS_MG2); bf16* MG = (bf16*)(ws + WS_MG);
#pragma unroll
        for (int ai = 0; ai < 2; ++ai)
#pragma unroll
            for (int m = 0; m < 4; ++m) { const size_t row = (size_t)(row0 + ai * 128 + m * 16);
#pragma unroll
                for (int bj = 0; bj < 2; ++bj) { const int col = col0 + bj * 128; const f32x4 v0 = acc[ai][bj][m][0], v1 = acc[ai][bj][m][1];
                    const v4u g = *(const v4u*)(GM + row * 2048 + col);
                    float r[8];
                    r[0] = v0[0] * sigmoidf_(bflo(g.x)); r[1] = v0[1] * sigmoidf_(bfhi(g.x)); r[2] = v0[2] * sigmoidf_(bflo(g.y)); r[3] = v0[3] * sigmoidf_(bfhi(g.y));
                    r[4] = v1[0] * sigmoidf_(bflo(g.z)); r[5] = v1[1] * sigmoidf_(bfhi(g.z)); r[6] = v1[2] * sigmoidf_(bflo(g.w)); r[7] = v1[3] * sigmoidf_(bfhi(g.w));
                    if (pass) { const v4u p = *(const v4u*)(MG2 + row * 1024 + col);
                        r[0] += bflo(p.x); r[1] += bfhi(p.x); r[2] += bflo(p.y); r[3] += bfhi(p.y); r[4] += bflo(p.z); r[5] += bfhi(p.z); r[6] += bflo(p.w); r[7] += bfhi(p.w); }
                    v4u w; w.x = cvt_pk_bf16(r[0], r[1]); w.y = cvt_pk_bf16(r[2], r[3]); w.z = cvt_pk_bf16(r[4], r[5]); w.w = cvt_pk_bf16(r[6], r[7]);
                    *(v4u*)((pass ? MG : MG2) + row * 1024 + col) = w; } }
    }
};
struct EpiMerge1 { static constexpr bool PRE = false, MID = true, PERM = true; unsigned char* ws;
    __device__ __forceinline__ void mid(f32x4 (&acc)[2][2][4][2], const Unit& u, int wr, int wc, int fr, int fq) const {
        const int row0 = u.pm * 256 + wr * 64 + fr, col0 = u.pn * 256 + wc * 32 + 8 * fq; const bf16* GM = (const bf16*)(ws + WS_GM);
#pragma unroll
        for (int ai = 0; ai < 2; ++ai)
#pragma unroll
            for (int m = 0; m < 4; ++m) { const size_t row = (size_t)(row0 + ai * 128 + m * 16);
#pragma unroll
                for (int bj = 0; bj < 2; ++bj) { const int col = col0 + bj * 128;
                    if (GM_U8) { const unsigned char* G8 = ws + WS_GM + row * 2048 + col; const v2u ga = *(const v2u*)G8, gb = *(const v2u*)(G8 + 1024);
#pragma unroll
                        for (int p = 0; p < 8; ++p) acc[ai][bj][m][p >> 2][p & 3] *= ub(p < 4 ? ga.x : ga.y, p & 3) * __builtin_amdgcn_rcpf(ub(p < 4 ? gb.x : gb.y, p & 3));
                        continue; }
                    const v4u ga = *(const v4u*)(GM + row * 2048 + col), gb = *(const v4u*)(GM + row * 2048 + 1024 + col);
                    const unsigned gaw[4] = {ga.x, ga.y, ga.z, ga.w}, gbw[4] = {gb.x, gb.y, gb.z, gb.w};
#pragma unroll
                    for (int p = 0; p < 4; ++p) {
                        const float r0 = (1.0f + __expf(-bflo(gbw[p]))) * __builtin_amdgcn_rcpf(1.0f + __expf(-bflo(gaw[p]))), r1 = (1.0f + __expf(-bfhi(gbw[p]))) * __builtin_amdgcn_rcpf(1.0f + __expf(-bfhi(gaw[p])));
                        acc[ai][bj][m][p >> 1][(p & 1) * 2] *= r0; acc[ai][bj][m][p >> 1][(p & 1) * 2 + 1] *= r1; } } }
    }
    __device__ __forceinline__ void operator()(const f32x4 (&acc)[2][2][4][2], const Unit& u, int wr, int wc, int fr, int fq) const {
        const int row0 = u.pm * 256 + wr * 64 + fr, col0 = u.pn * 256 + wc * 32 + 8 * fq; const bf16* GM = (const bf16*)(ws + WS_GM) + 1024; unsigned char* MG8 = ws + WS_MG;
#pragma unroll
        for (int ai = 0; ai < 2; ++ai)
#pragma unroll
            for (int m = 0; m < 4; ++m) { const size_t row = (size_t)(row0 + ai * 128 + m * 16);
#pragma unroll
                for (int bj = 0; bj < 2; ++bj) { const int col = col0 + bj * 128; const f32x4 v0 = acc[ai][bj][m][0], v1 = acc[ai][bj][m][1];
                    if (GM_U8) { const v2u g8 = *(const v2u*)(ws + WS_GM + row * 2048 + 1024 + col); constexpr float GS = MG8_SCALE / 255.0f;
                        v2u w; w.x = pack_fp8x4(v0[0] * ub(g8.x, 0) * GS, v0[1] * ub(g8.x, 1) * GS, v0[2] * ub(g8.x, 2) * GS, v0[3] * ub(g8.x, 3) * GS);
                        w.y = pack_fp8x4(v1[0] * ub(g8.y, 0) * GS, v1[1] * ub(g8.y, 1) * GS, v1[2] * ub(g8.y, 2) * GS, v1[3] * ub(g8.y, 3) * GS);
                        *(v2u*)(MG8 + row * 1024 + col) = w; continue; }
                    const v4u g = *(const v4u*)(GM + row * 2048 + col);
                    v2u w; w.x = pack_fp8x4(v0[0] * sigmoidf_(bflo(g.x)) * MG8_SCALE, v0[1] * sigmoidf_(bfhi(g.x)) * MG8_SCALE, v0[2] * sigmoidf_(bflo(g.y)) * MG8_SCALE, v0[3] * sigmoidf_(bfhi(g.y)) * MG8_SCALE);
                    w.y = pack_fp8x4(v1[0] * sigmoidf_(bflo(g.z)) * MG8_SCALE, v1[1] * sigmoidf_(bfhi(g.z)) * MG8_SCALE, v1[2] * sigmoidf_(bflo(g.w)) * MG8_SCALE, v1[3] * sigmoidf_(bfhi(g.w)) * MG8_SCALE);
                    *(v2u*)(MG8 + row * 1024 + col) = w; } }
    }
};
struct EpiResid { static constexpr bool PRE = false, MID = false, PERM = false; const float* xin; float* xout; const float* gate;
    __device__ __forceinline__ void operator()(const f32x4 (&acc)[2][2][4][2], const Unit& u, int wr, int wc, int fr, int fq) const {
        const int row0 = u.pm * 256 + wr * 64 + fr, col0 = u.pn * 256 + wc * 32 + 4 * fq; const int b = (u.pm * 256) / S;
        f32x4 gv[2][2];
#pragma unroll
        for (int bj = 0; bj < 2; ++bj)
#pragma unroll
            for (int n = 0; n < 2; ++n) gv[bj][n] = *(const f32x4*)(gate + (size_t)b * 6144 + col0 + bj * 128 + n * 16);
#pragma unroll
        for (int ai = 0; ai < 2; ++ai)
#pragma unroll
            for (int m = 0; m < 4; ++m) { const size_t off = (size_t)(row0 + ai * 128 + m * 16) * D + col0;
#pragma unroll
                for (int bj = 0; bj < 2; ++bj)
#pragma unroll
                    for (int n = 0; n < 2; ++n) { const f32x4 xi = *(const f32x4*)(xin + off + bj * 128 + n * 16); *(f32x4*)(xout + off + bj * 128 + n * 16) = xi + gv[bj][n] * acc[ai][bj][m][n]; } }
    }
};
struct EpiResidB { static constexpr bool PRE = false, MID = false, PERM = true; const float* xin32; const bf16* xin16; bf16* xout; const float* gate;
    __device__ __forceinline__ void operator()(const f32x4 (&acc)[2][2][4][2], const Unit& u, int wr, int wc, int fr, int fq) const {
        const int row0 = u.pm * 256 + wr * 64 + fr, col0 = u.pn * 256 + wc * 32 + 8 * fq; const int b = (u.pm * 256) / S;
        f32x4 gv[2][2];
#pragma unroll
        for (int bj = 0; bj < 2; ++bj)
#pragma unroll
            for (int n = 0; n < 2; ++n) gv[bj][n] = *(const f32x4*)(gate + (size_t)b * 6144 + col0 + bj * 128 + 4 * n);
#pragma unroll
        for (int ai = 0; ai < 2; ++ai)
#pragma unroll
            for (int m = 0; m < 4; ++m) { const size_t off = (size_t)(row0 + ai * 128 + m * 16) * D + col0;
#pragma unroll
                for (int bj = 0; bj < 2; ++bj) { f32x4 x0, x1;
                    if (xin32) { x0 = *(const f32x4*)(xin32 + off + bj * 128); x1 = *(const f32x4*)(xin32 + off + bj * 128 + 4); }
                    else { const v4u w = *(const v4u*)(xin16 + off + bj * 128); x0 = (f32x4){bflo(w.x), bfhi(w.x), bflo(w.y), bfhi(w.y)}; x1 = (f32x4){bflo(w.z), bfhi(w.z), bflo(w.w), bfhi(w.w)}; }
                    x0 = x0 + gv[bj][0] * acc[ai][bj][m][0]; x1 = x1 + gv[bj][1] * acc[ai][bj][m][1];
                    v4u o; o.x = cvt_pk_bf16(x0[0], x0[1]); o.y = cvt_pk_bf16(x0[2], x0[3]); o.z = cvt_pk_bf16(x1[0], x1[1]); o.w = cvt_pk_bf16(x1[2], x1[3]);
                    *(v4u*)(xout + off + bj * 128) = o; } }
    }
};
template <bool OUT8> struct EpiSwiglu { static constexpr bool PRE = true, MID = false, PERM = true; bf16* hid; const float* bias; LAS unsigned char* blds;
    __device__ __forceinline__ void pre(const Unit& u, int lane) const { __builtin_amdgcn_global_load_lds((const unsigned*)(bias + (size_t)u.e * 2048 + u.pn * 256 + 4 * lane), (LAS unsigned*)(blds + u.par * 1024), 16, 0, 0); }
    __device__ __forceinline__ void operator()(const f32x4 (&acc)[2][2][4][2], const Unit& u, int wr, int wc, int fr, int fq) const {
        const int row0 = u.pm * 256 + wr * 64 + fr, col0 = u.pn * 256 + wc * 32 + 8 * fq;
        f32x4 bv[2][2];
#pragma unroll
        for (int bj = 0; bj < 2; ++bj)
#pragma unroll
            for (int n = 0; n < 2; ++n) bv[bj][n] = *(const LAS f32x4*)(blds + u.par * 1024 + (wc * 32 + 8 * fq + bj * 128 + 4 * n) * 4);
#pragma unroll
        for (int ai = 0; ai < 2; ++ai)
#pragma unroll
            for (int m = 0; m < 4; ++m) { bf16* rowp = hid + (size_t)(row0 + ai * 128 + m * 16) * 1024 + (col0 >> 1);
#pragma unroll
                for (int bj = 0; bj < 2; ++bj) { const f32x4 v0 = acc[ai][bj][m][0] + bv[bj][0], v1 = acc[ai][bj][m][1] + bv[bj][1];
                    float hq[4];
#pragma unroll
                    for (int p = 0; p < 4; ++p) { float gl = p < 2 ? v0[2 * p] : v1[2 * p - 4], li = p < 2 ? v0[2 * p + 1] : v1[2 * p - 3];
                        gl = fminf(gl, 7.0f); li = fminf(fmaxf(li, -7.0f), 7.0f);
                        hq[p] = gl * __builtin_amdgcn_rcpf(1.0f + __builtin_amdgcn_exp2f(gl * (-1.702f * 1.4426950408889634f))) * (OUT8 ? li * HID8_SCALE + HID8_SCALE : li + 1.0f); }
                    if constexpr (OUT8) { unsigned char* r8 = (unsigned char*)hid + (size_t)(row0 + ai * 128 + m * 16) * 1024 + (col0 >> 1) + bj * 64;
                        *(unsigned*)r8 = pack_fp8x4_raw(hq[0], hq[1], hq[2], hq[3]); }
                    else { v2u w; w.x = cvt_pk_bf16(hq[0], hq[1]); w.y = cvt_pk_bf16(hq[2], hq[3]); *(v2u*)(rowp + bj * 64) = w; } } }
    }
};
struct EpiBias { static constexpr bool PRE = true, MID = false, PERM = true; bf16* eo; const float* bias; LAS unsigned char* blds;
    __device__ __forceinline__ void pre(const Unit& u, int lane) const { __builtin_amdgcn_global_load_lds((const unsigned*)(bias + (size_t)u.e * 1024 + u.pn * 256 + 4 * lane), (LAS unsigned*)(blds + u.par * 1024), 16, 0, 0); }
    __device__ __forceinline__ void operator()(const f32x4 (&acc)[2][2][4][2], const Unit& u, int wr, int wc, int fr, int fq) const {
        const int row0 = u.pm * 256 + wr * 64 + fr, col0 = u.pn * 256 + wc * 32 + 8 * fq;
        f32x4 bv[2][2];
#pragma unroll
        for (int bj = 0; bj < 2; ++bj)
#pragma unroll
            for (int n = 0; n < 2; ++n) bv[bj][n] = *(const LAS f32x4*)(blds + u.par * 1024 + (wc * 32 + 8 * fq + bj * 128 + 4 * n) * 4);
#pragma unroll
        for (int ai = 0; ai < 2; ++ai)
#pragma unroll
            for (int m = 0; m < 4; ++m) { bf16* rowp = eo + (size_t)(row0 + ai * 128 + m * 16) * 1024 + col0; unsigned char* rowp8 = (unsigned char*)eo + (size_t)(row0 + ai * 128 + m * 16) * 1024 + col0;
#pragma unroll
                for (int bj = 0; bj < 2; ++bj) { const f32x4 v0 = acc[ai][bj][m][0] + bv[bj][0], v1 = acc[ai][bj][m][1] + bv[bj][1];
                    if (EO_FP8) { const f32x4 x0 = v0 * EO8_SCALE, x1 = v1 * EO8_SCALE; v2u w; w.x = pack_fp8x4(x0[0], x0[1], x0[2], x0[3]); w.y = pack_fp8x4(x1[0], x1[1], x1[2], x1[3]); *(v2u*)(rowp8 + bj * 128) = w; }
                    else { v4u w; w.x = cvt_pk_bf16(v0[0], v0[1]); w.y = cvt_pk_bf16(v0[2], v0[3]); w.z = cvt_pk_bf16(v1[0], v1[1]); w.w = cvt_pk_bf16(v1[2], v1[3]);
                    *(v4u*)(rowp + bj * 128) = w; } } }
    }
};

__device__ __forceinline__ bf16* wsb(const Frame& F, size_t off) { return (bf16*)(F.ws + off); }
__device__ __forceinline__ float* wsf(const Frame& F, size_t off) { return (float*)(F.ws + off); }
__device__ __forceinline__ int* wsi(const Frame& F, size_t off) { return (int*)(F.ws + off); }

__device__ __forceinline__ void tr_item(const float* src, size_t ldn, int k0, int ns0, int nvalid, bf16* dst, size_t ldk, LAS float* scr, int lane) {
    const int n = lane & 31;
#pragma unroll 16
    for (int i = 0; i < 32; ++i) { const int kk = 2 * i + (lane >> 5); scr[kk * 33 + n] = (n < nvalid) ? src[(size_t)(k0 + kk) * ldn + ns0 + n] : 0.f; }
    LDS_WAIT(); asm volatile("" ::: "memory");
    const int c = lane & 7;
#pragma unroll
    for (int j = 0; j < 4; ++j) { const int nn = (lane >> 3) + 8 * j; const LAS float* s = scr + (8 * c) * 33 + nn;
        v4u o; o.x = pk2(s[0 * 33], s[1 * 33]); o.y = pk2(s[2 * 33], s[3 * 33]); o.z = pk2(s[4 * 33], s[5 * 33]); o.w = pk2(s[6 * 33], s[7 * 33]);
        *(v4u*)(dst + (size_t)nn * ldk + k0 + 8 * c) = o; }
    LDS_WAIT(); asm volatile("" ::: "memory");
}
__device__ __forceinline__ void tr_item8(const float* src, size_t ldn, int k0, int ns0, int nvalid, unsigned char* dst, size_t ldk, LAS float* scr, int lane, float sc) {
    const int n = lane & 31;
#pragma unroll 16
    for (int i = 0; i < 32; ++i) { const int kk = 2 * i + (lane >> 5); scr[kk * 33 + n] = (n < nvalid) ? src[(size_t)(k0 + kk) * ldn + ns0 + n] * sc : 0.f; }
    LDS_WAIT(); asm volatile("" ::: "memory");
    const int c = lane & 7;
#pragma unroll
    for (int j = 0; j < 4; ++j) { const int nn = (lane >> 3) + 8 * j; const LAS float* s = scr + (8 * c) * 33 + nn;
        v2u o; o.x = pack_fp8x4(s[0 * 33], s[1 * 33], s[2 * 33], s[3 * 33]); o.y = pack_fp8x4(s[4 * 33], s[5 * 33], s[6 * 33], s[7 * 33]);
        *(v2u*)(dst + (size_t)nn * ldk + k0 + 8 * c) = o; }
    LDS_WAIT(); asm volatile("" ::: "memory");
}
template <int R>
__device__ __forceinline__ void matvec_item(Frame& F, const float* W, size_t ldn, int K, int n0, const LAS float* a, LAS float* red, const float* bias, float* out, size_t ostride) {
    const int kper = K / NWAVES, kb = F.wave * kper; float acc[R];
#pragma unroll
    for (int r = 0; r < R; ++r) acc[r] = 0.f;
#pragma unroll 8
    for (int k = kb; k < kb + kper; ++k) { const float w = W[(size_t)k * ldn + n0 + F.lane];
#pragma unroll
        for (int r = 0; r < R; ++r) acc[r] += a[r * K + k] * w; }
#pragma unroll
    for (int r = 0; r < R; ++r) red[(F.wave * R + r) * 64 + F.lane] = acc[r];
    __syncthreads();
    if (F.tid < R * 64) { const int r = F.tid >> 6, ln = F.tid & 63; float s = bias ? bias[n0 + ln] : 0.f;
#pragma unroll
        for (int w = 0; w < NWAVES; ++w) s += red[(w * R + r) * 64 + ln];
        out[(size_t)r * ostride + n0 + ln] = s; }
    __syncthreads();
}
__device__ __forceinline__ void p0_prologue(Frame& F) {
    LAS float* avec = (LAS float*)F.lds; LAS float* red = (LAS float*)(F.lds + 16384);
    int loaded = -1;
    for (int it = blockIdx.x; it < NL * 96 + NL * 2 * 4; it += F.G) {
        if (it < NL * 96) { const int l = it / 96, cb = it % 96;
            if (loaded != 0) { __syncthreads(); for (int i = F.tid; i < NB * 1024; i += NTHR) { const float c = F.c[i]; avec[i] = c / (1.0f + __expf(-c)); } loaded = 0; __syncthreads(); }
            matvec_item<4>(F, F.w_ada + (size_t)l * 1024 * 6144, 6144, 1024, cb * 64, avec, red, F.b_ada + (size_t)l * 6144, wsf(F, WS_MOD) + (size_t)l * NB * 6144, 6144);
        } else { const int r = it - NL * 96, lk = r >> 2, cb = r & 3;
            __syncthreads(); for (int i = F.tid; i < 2048; i += NTHR) avec[i] = F.cmp_pos[(size_t)lk * 2048 + i]; loaded = 1 + lk; __syncthreads();
            matvec_item<1>(F, F.cmp_w1 + (size_t)lk * 2048 * 256, 256, 2048, cb * 64, avec, red, nullptr, wsf(F, WS_POSB) + (size_t)lk * 256, 0);
        }
    }
    __syncthreads();
    LAS float* scr = (LAS float*)(F.lds + F.wave * 16384);
    const int gw = F.vcu * NWAVES + F.wave, NGW = F.G * NWAVES;
    constexpr int I_WIN = NL * 136 * 16, I_WBR = NL * 2 * 32 * 8, I_WOUT = NL * 32 * 16, I_WC1 = NL * 2 * 2 * 8 * 16, I_WUP = BG_CONV ? 0 : NL * NE * 64 * 16, I_WDN = BG_CONV ? 0 : NL * NE * 32 * 16;
    constexpr int NITEMS = I_WIN + I_WBR + I_WOUT + I_WC1 + I_WUP + I_WDN;
    for (int it = gw; it < NITEMS; it += NGW) {
        int r = it;
        if (r < I_WIN) { const int l = r / (136 * 16), rr = r % (136 * 16), nb = rr / 16, kb = rr % 16, d0 = nb * 32;
            int ns0 = 0, nvalid = 0; if (d0 < 4096) { ns0 = d0 + (d0 >= 1280 ? 24 : 0); nvalid = 32; } else if (d0 == 4096) { ns0 = 1280; nvalid = 24; }
            if (Z_FP8) tr_item8(F.w_in + (size_t)l * 1024 * DIN, DIN, kb * 64, ns0, nvalid, F.ws + WS_WIN + ((size_t)l * NZ + d0) * 1024, 1024, scr, F.lane, W8_SCALE);
            else tr_item(F.w_in + (size_t)l * 1024 * DIN, DIN, kb * 64, ns0, nvalid, wsb(F, WS_WIN) + ((size_t)l * NZ + d0) * 1024, 1024, scr, F.lane);
            continue; } r -= I_WIN;
        if (r < I_WBR) { const int lb = r / 256, rr = r % 256, nb = rr / 8, kb = rr % 8;
            if (MIX_FP8) tr_item8(F.w_branch + (size_t)lb * 512 * 1024, 1024, kb * 64, nb * 32, 32, F.ws + WS_WBR + ((size_t)(lb >> 1) * 1024 + nb * 32) * 1024 + (lb & 1) * 512, 1024, scr, F.lane, W8_SCALE);
            else tr_item(F.w_branch + (size_t)lb * 512 * 1024, 1024, kb * 64, nb * 32, 32, wsb(F, WS_WBR) + ((size_t)lb * 1024 + nb * 32) * 512, 512, scr, F.lane);
            continue; } r -= I_WBR;
        if (r < I_WOUT) { const int l = r / 512, rr = r % 512, nb = rr / 16, kb = rr % 16;
            if (MIX_FP8) tr_item8(F.w_out + (size_t)l * 1024 * 1024, 1024, kb * 64, nb * 32, 32, F.ws + WS_WOUT + ((size_t)l * 1024 + nb * 32) * 1024, 1024, scr, F.lane, W8_SCALE);
            else tr_item(F.w_out + (size_t)l * 1024 * 1024, 1024, kb * 64, nb * 32, 32, wsb(F, WS_WOUT) + ((size_t)l * 1024 + nb * 32) * 1024, 1024, scr, F.lane);
            continue; } r -= I_WOUT;
        if (r < I_WC1) { const int lk = r / 256, half = (r / 128) & 1, rr = r % 128, nb = rr / 16, kb = rr % 16;
            tr_item(F.cmp_w1 + ((size_t)lk * 2048 + half * 1024) * 256, 256, kb * 64, nb * 32, 32, wsb(F, WS_WC1) + ((size_t)lk * 512 + half * 256 + nb * 32) * 1024, 1024, scr, F.lane); continue; } r -= I_WC1;
        if (r < I_WUP) { const int le = r / 1024, rr = r % 1024, nb = rr / 16, kb = rr % 16;
            if (MOE_FP8_UP) tr_item8(F.w_up + (size_t)le * 1024 * 2048, 2048, kb * 64, nb * 32, 32, F.ws + WS_WUP + ((size_t)le * 2048 + nb * 32) * 1024, 1024, scr, F.lane, W8_SCALE);
            else tr_item(F.w_up + (size_t)le * 1024 * 2048, 2048, kb * 64, nb * 32, 32, wsb(F, WS_WUP) + ((size_t)le * 2048 + nb * 32) * 1024, 1024, scr, F.lane);
            continue; } r -= I_WUP;
        { const int le = r / 512, rr = r % 512, nb = rr / 16, kb = rr % 16;
            if (MOE_FP8_DN) tr_item8(F.w_down + (size_t)le * 1024 * 1024, 1024, kb * 64, nb * 32, 32, F.ws + WS_WDN + ((size_t)le * 1024 + nb * 32) * 1024, 1024, scr, F.lane, W8_SCALE);
            else tr_item(F.w_down + (size_t)le * 1024 * 1024, 1024, kb * 64, nb * 32, 32, wsb(F, WS_WDN) + ((size_t)le * 1024 + nb * 32) * 1024, 1024, scr, F.lane); }
    }
}

__device__ __forceinline__ void load_row16(const float* row, int lane, f32x4 (&v)[4]) { const f32x4* p = (const f32x4*)row + lane;
#pragma unroll
    for (int j = 0; j < 4; ++j) v[j] = p[64 * j]; }
__device__ __forceinline__ void load_row16_bf(const bf16* row, int lane, f32x4 (&v)[4]) { const v2u* p = (const v2u*)row + lane;
#pragma unroll
    for (int j = 0; j < 4; ++j) { const v2u w = p[64 * j]; v[j] = (f32x4){bflo(w.x), bfhi(w.x), bflo(w.y), bfhi(w.y)}; } }
__device__ __forceinline__ float row_rstd(const f32x4 (&v)[4]) { float s = 0.f;
#pragma unroll
    for (int j = 0; j < 4; ++j) s += (v[j].x * v[j].x + v[j].y * v[j].y) + (v[j].z * v[j].z + v[j].w * v[j].w);
    return __builtin_amdgcn_rsqf(wave_sum(s) * (1.0f / D) + RMS_EPS); }
__device__ __forceinline__ void load_mod(const float* g, const float* sc, const float* sh, int lane, f32x4 (&A)[4], f32x4 (&Bv)[4]) {
#pragma unroll
    for (int j = 0; j < 4; ++j) { const f32x4 gg = ((const f32x4*)g)[64 * j + lane], s = ((const f32x4*)sc)[64 * j + lane]; A[j] = gg * (s + 1.0f); Bv[j] = ((const f32x4*)sh)[64 * j + lane]; } }
__device__ __forceinline__ void store_row_bf16(bf16* row, int lane, const f32x4 (&h)[4]) { v2u* o = (v2u*)row + lane;
#pragma unroll
    for (int j = 0; j < 4; ++j) { v2u w; w.x = cvt_pk_bf16(h[j].x, h[j].y); w.y = cvt_pk_bf16(h[j].z, h[j].w); o[64 * j] = w; } }

__device__ __forceinline__ void store_row_fp8(unsigned char* row, int lane, const f32x4 (&h)[4], float sc) { unsigned* o = (unsigned*)row + lane;
#pragma unroll
    for (int j = 0; j < 4; ++j) o[64 * j] = pack_fp8x4(h[j].x * sc, h[j].y * sc, h[j].z * sc, h[j].w * sc); }
__device__ __forceinline__ void p_norm0(Frame& F) {
    const int gw = F.vcu * NWAVES + F.wave, NGW = F.G * NWAVES, per = T / NGW;
    const float* mod = wsf(F, WS_MOD);
    for (int m0 = gw * 16; m0 < T; m0 += NGW * 16) {
        const int b = m0 / S; f32x4 A[4], Bv[4]; load_mod(F.g_mix, mod + (size_t)b * 6144 + 1024, mod + (size_t)b * 6144, F.lane, A, Bv);
        for (int i = 0; i < 16; ++i) { const int m = m0 + i; f32x4 v[4]; load_row16(F.x + (size_t)m * D, F.lane, v); const float rs = row_rstd(v);
#pragma unroll
            for (int j = 0; j < 4; ++j) v[j] = v[j] * rs * A[j] + Bv[j];
            if (Z_FP8) store_row_fp8(F.ws + WS_H8 + (size_t)m * D, F.lane, v, H8_SCALE); else store_row_bf16(wsb(F, WS_H) + (size_t)m * D, F.lane, v); }
    }
    (void)per;
}

__device__ __forceinline__ void build_tiles(Frame& F, int l) {
    __syncthreads();
    if (F.tid == 0) { int acc = 0;
        for (int e = 0; e < NE; ++e) { const int c = (int)__hip_atomic_load(F.ctl + CW_CNT + l * NE + e, RLX_AGENT); F.MISC[MW_CNT + e] = (unsigned)c; F.MISC[MW_TSTART + e] = (unsigned)acc; acc += (c + 255) >> 8; }
        F.MISC[MW_TSTART + 32] = (unsigned)acc; }
    __syncthreads();
    { volatile LAS unsigned char* texp = (volatile LAS unsigned char*)F.MISC + MB_TEXP; const int nt = (int)F.MISC[MW_TSTART + 32];
      for (int rt = F.tid; rt < nt; rt += NTHR) { int e = 0;
          for (int j = 1; j < 32; ++j) e = ((int)F.MISC[MW_TSTART + j] <= rt) ? j : e;
          texp[rt] = (unsigned char)e; } }
    __syncthreads();
}

__device__ __forceinline__ void p_router(Frame& F, int l) {
    LAS float* hb = (LAS float*)(F.lds + F.wave * 4096);
    LAS int* lcnt = (LAS int*)(F.lds + 32768); LAS int* lbase = lcnt + 32; LAS int* sel = lcnt + 64;
    const float* mod = wsf(F, WS_MOD) + (size_t)l * NB * 6144; const float* xb = wsf(F, WS_XB);
    const float* Wr = F.w_router + (size_t)l * 1024 * 32;
    for (int chunk = blockIdx.x; chunk < T / 128; chunk += F.G) {
        if (F.tid < 32) lcnt[F.tid] = 0;
        __syncthreads();
        const int b = (chunk * 128) / S; f32x4 A[4], Bv[4]; load_mod(F.g_ffn + (size_t)l * D, mod + (size_t)b * 6144 + 4 * 1024, mod + (size_t)b * 6144 + 3 * 1024, F.lane, A, Bv);
        const int e = F.lane & 31, half = F.lane >> 5; const float br = F.b_router[l * 32 + e];
        for (int i = 0; i < 16; ++i) { const int tl = F.wave * 16 + i, t = chunk * 128 + tl;
            f32x4 v[4]; load_row16(xb + (size_t)t * D, F.lane, v); const float rs = row_rstd(v);
#pragma unroll
            for (int j = 0; j < 4; ++j) { v[j] = v[j] * rs * A[j] + Bv[j]; ((LAS f32x4*)hb)[64 * j + F.lane] = v[j]; }
            if (MOE_FP8_UP) { unsigned* h8 = (unsigned*)(F.ws + WS_H8 + (size_t)t * D) + F.lane;
#pragma unroll
                for (int j = 0; j < 4; ++j) h8[64 * j] = pack_fp8x4(v[j].x * H8_SCALE, v[j].y * H8_SCALE, v[j].z * H8_SCALE, v[j].w * H8_SCALE); }
            else store_row_bf16(wsb(F, WS_H) + (size_t)t * D, F.lane, v);
            LDS_WAIT(); asm volatile("" ::: "memory");
            float acc = 0.f; const float* wp = Wr + (size_t)(half * 512) * 32 + e; const LAS float* hp = hb + half * 512;
#pragma unroll 16
            for (int k = 0; k < 512; ++k) acc += hp[k] * wp[(size_t)k * 32];
            acc += __shfl_xor(acc, 32);
            float val = acc + br; int idx = e;
            float tv[4]; int ti[4];
#pragma unroll
            for (int r = 0; r < 4; ++r) { float bv = val; int bi = idx;
#pragma unroll
                for (int o = 16; o >= 1; o >>= 1) { const float ov = __shfl_xor(bv, o); const int oi = __shfl_xor(bi, o); if (ov > bv || (ov == bv && oi < bi)) { bv = ov; bi = oi; } }
                tv[r] = bv; ti[r] = bi; if (e == bi) val = -INFINITY; }
            const float e1 = __expf(tv[1] - tv[0]), e2 = __expf(tv[2] - tv[0]), e3 = __expf(tv[3] - tv[0]), inv = 1.0f / (1.0f + e1 + e2 + e3);
            if (F.lane == 0) { const float gk[4] = {inv, e1 * inv, e2 * inv, e3 * inv};
#pragma unroll
                for (int r = 0; r < 4; ++r) { const int rk = atomicAdd((int*)&lcnt[ti[r]], 1); sel[tl * 4 + r] = ti[r] | (rk << 8); wsf(F, WS_GW)[(size_t)t * 4 + r] = gk[r]; } }
            LDS_WAIT(); asm volatile("" ::: "memory");
        }
        __syncthreads();
        if (F.tid < 32) { const int c = lcnt[F.tid]; lbase[F.tid] = c ? (int)__hip_atomic_fetch_add(F.ctl + CW_CNT + l * NE + F.tid, (unsigned)c, RLX_AGENT) : 0; }
        __syncthreads();
        { const int w = sel[F.tid], ee = w & 255, pos = lbase[ee] + (w >> 8), t = chunk * 128 + (F.tid >> 2);
          wsi(F, WS_LIST)[(size_t)ee * T + pos] = t; wsi(F, WS_TOPI)[(size_t)t * 4 + (F.tid & 3)] = ee | (pos << 8); }
        __syncthreads();
    }
}

__device__ __forceinline__ void p_router2(Frame& F, int l) {
    LAS float* Wl = (LAS float*)F.lds;
    LAS float* AB = (LAS float*)(F.lds + MISC_OFF + 1024);
    LAS int* lcnt = (LAS int*)(F.lds + MISC_OFF + 1024 + 8192); LAS int* lbase = lcnt + 32; LAS int* sel = lcnt + 64; LAS float* rst = (LAS float*)(sel + 512);
    const float* mod = wsf(F, WS_MOD) + (size_t)l * NB * 6144; const float* xb = wsf(F, WS_XB);
    { const f32x4* Wr = (const f32x4*)(F.w_router + (size_t)l * 1024 * 32);
      for (int idx = F.tid; idx < 1024 * 8; idx += NTHR) { const int k = idx >> 3, c4 = idx & 7; *(LAS f32x4*)(Wl + k * 32 + ((4 * c4) ^ (((k >> 2) & 1) << 4))) = Wr[idx]; } }
    int curb = -1;
    for (int chunk = blockIdx.x; chunk < T / 128; chunk += F.G) {
        const int b = (chunk * 128) / S;
        __syncthreads();
        if (b != curb) { for (int i = F.tid; i < 1024; i += NTHR) { AB[i] = F.g_ffn[(size_t)l * D + i] * (1.0f + mod[(size_t)b * 6144 + 4 * 1024 + i]); AB[1024 + i] = mod[(size_t)b * 6144 + 3 * 1024 + i]; } curb = b; }
        if (F.tid < 32) lcnt[F.tid] = 0;
        __syncthreads();
        const int t0 = chunk * 128 + F.wave * 16;
#if RES_BF16
        v2u xq[2][4];
        { const v2u* p = (const v2u*)(wsb(F, WS_XB) + (size_t)t0 * D) + F.lane;
#pragma unroll
          for (int j = 0; j < 4; ++j) xq[0][j] = p[64 * j]; }
#endif
#pragma unroll
        for (int i = 0; i < 16; ++i) { const int t = t0 + i; f32x4 v[4];
#if RES_BF16
            if (i + 1 < 16) { const v2u* p = (const v2u*)(wsb(F, WS_XB) + (size_t)(t + 1) * D) + F.lane;
#pragma unroll
                for (int j = 0; j < 4; ++j) xq[(i + 1) & 1][j] = p[64 * j]; }
#pragma unroll
            for (int j = 0; j < 4; ++j) { const v2u w = xq[i & 1][j]; v[j] = (f32x4){bflo(w.x), bfhi(w.x), bflo(w.y), bfhi(w.y)}; }
#else
            load_row16(xb + (size_t)t * D, F.lane, v);
#endif
            const float rs = row_rstd(v);
#pragma unroll
            for (int j = 0; j < 4; ++j) v[j] = v[j] * rs * ((const LAS f32x4*)AB)[64 * j + F.lane] + ((const LAS f32x4*)(AB + 1024))[64 * j + F.lane];
            if (MOE_FP8_UP) store_row_fp8(F.ws + WS_H8 + (size_t)t * D, F.lane, v, H8_SCALE); else store_row_bf16(wsb(F, WS_H) + (size_t)t * D, F.lane, v);
            if (F.lane == 0) rst[F.wave * 16 + i] = rs; }
        LDS_WAIT(); asm volatile("" ::: "memory");
        const int r = F.lane & 15, kq = F.lane >> 4; const float rsr = rst[F.wave * 16 + r];
        const float* xrow = xb + (size_t)(t0 + r) * D + 4 * kq; const LAS float* wb = Wl + (4 * kq) * 32 + (r ^ ((kq & 1) << 4));
        const int e0 = r ^ ((kq & 1) << 4), d16 = (e0 ^ 16) - e0;
        f32x4 acc0 = {0.f, 0.f, 0.f, 0.f}, acc1 = {0.f, 0.f, 0.f, 0.f};
        const bf16* xrow16 = wsb(F, WS_XB) + (size_t)(t0 + r) * D + 4 * kq;
#pragma unroll 4
        for (int ip = 0; ip < 64; ++ip) { f32x4 x4; if (RES_BF16) { const v2u w = *(const v2u*)(xrow16 + 16 * ip); x4 = (f32x4){bflo(w.x), bfhi(w.x), bflo(w.y), bfhi(w.y)}; } else x4 = *(const f32x4*)(xrow + 16 * ip);
            const f32x4 h4 = x4 * rsr * *(const LAS f32x4*)(AB + 16 * ip + 4 * kq) + *(const LAS f32x4*)(AB + 1024 + 16 * ip + 4 * kq);
#pragma unroll
            for (int c = 0; c < 4; ++c) { const LAS float* wp = wb + (16 * ip + c) * 32; const float w0 = wp[0], w1 = wp[d16];
                acc0 = __builtin_amdgcn_mfma_f32_16x16x4f32(h4[c], w0, acc0, 0, 0, 0); acc1 = __builtin_amdgcn_mfma_f32_16x16x4f32(h4[c], w1, acc1, 0, 0, 0); } }
        const float br0 = F.b_router[l * 32 + r], br1 = F.b_router[l * 32 + 16 + r];
        float tv[4][4]; int ti[4][4];
#pragma unroll
        for (int jj = 0; jj < 4; ++jj) { float va = acc0[jj] + br0, vb = acc1[jj] + br1;
#pragma unroll
            for (int rr = 0; rr < 4; ++rr) { float bv = va >= vb ? va : vb; int bi = va >= vb ? r : r + 16;
#pragma unroll
                for (int o = 0; o < 4; ++o) { const float ov = o == 0 ? dpp_x1(bv) : o == 1 ? dpp_x2(bv) : o == 2 ? dpp_hm(bv) : dpp_rm(bv); const int oi = o == 0 ? dpp_x1i(bi) : o == 1 ? dpp_x2i(bi) : o == 2 ? dpp_hmi(bi) : dpp_rmi(bi); if (ov > bv || (ov == bv && oi < bi)) { bv = ov; bi = oi; } }
                tv[jj][rr] = bv; ti[jj][rr] = bi; if (bi == r) va = -INFINITY; if (bi == r + 16) vb = -INFINITY; } }
        if (r == 0) {
#pragma unroll
            for (int jj = 0; jj < 4; ++jj) { const int tl = F.wave * 16 + 4 * kq + jj; const int t = chunk * 128 + tl;
                const float e1 = __expf(tv[jj][1] - tv[jj][0]), e2 = __expf(tv[jj][2] - tv[jj][0]), e3 = __expf(tv[jj][3] - tv[jj][0]), inv = 1.0f / (1.0f + e1 + e2 + e3);
                const float gk[4] = {inv, e1 * inv, e2 * inv, e3 * inv};
#pragma unroll
                for (int rr = 0; rr < 4; ++rr) { const int rk = atomicAdd((int*)&lcnt[ti[jj][rr]], 1); sel[tl * 4 + rr] = ti[jj][rr] | (rk << 8); wsf(F, WS_GW)[(size_t)t * 4 + rr] = gk[rr]; } } }
        __syncthreads();
        if (F.tid < 32) { const int c = lcnt[F.tid]; lbase[F.tid] = c ? (int)__hip_atomic_fetch_add(F.ctl + CW_CNT + l * NE + F.tid, (unsigned)c, RLX_AGENT) : 0; }
        __syncthreads();
        { const int w = sel[F.tid], ee = w & 255, pos = lbase[ee] + (w >> 8), t = chunk * 128 + (F.tid >> 2);
          wsi(F, WS_LIST)[(size_t)ee * T + pos] = t; wsi(F, WS_TOPI)[(size_t)t * 4 + (F.tid & 3)] = ee | (pos << 8); }
    }
}

__device__ __forceinline__ void p_combine(Frame& F, int l) {
    build_tiles(F, l);
    const int gw = F.vcu * NWAVES + F.wave, NGW = F.G * NWAVES;
    const float* mod = wsf(F, WS_MOD) + (size_t)l * NB * 6144; const float* xb = wsf(F, WS_XB); const bf16* eo = wsb(F, WS_EO);
    for (int m0 = gw * 16; m0 < T; m0 += NGW * 16) {
        const int b = m0 / S; f32x4 A[4], Bv[4], ga[4];
#pragma unroll
        for (int j = 0; j < 4; ++j) ga[j] = ((const f32x4*)(mod + (size_t)b * 6144 + 5 * 1024))[64 * j + F.lane];
        if (l + 1 < NL) { const float* mod1 = wsf(F, WS_MOD) + (size_t)(l + 1) * NB * 6144 + (size_t)b * 6144; load_mod(F.g_mix + (size_t)(l + 1) * D, mod1 + 1024, mod1, F.lane, A, Bv); }
        else {
#pragma unroll
            for (int j = 0; j < 4; ++j) { A[j] = ((const f32x4*)F.g_final)[64 * j + F.lane]; Bv[j] = (f32x4){0.f, 0.f, 0.f, 0.f}; } }
#if RES_BF16
        const int4 wall = ((const int4*)wsi(F, WS_TOPI))[m0 + (F.lane & 15)]; const f32x4 gall = ((const f32x4*)wsf(F, WS_GW))[m0 + (F.lane & 15)];
        const float gax = gall.x, gay = gall.y, gaz = gall.z, gaw = gall.w; const int gbx = __builtin_bit_cast(int, gax), gby = __builtin_bit_cast(int, gay), gbz = __builtin_bit_cast(int, gaz), gbw = __builtin_bit_cast(int, gaw);
        v2u xbr[2][4], eor[2][4][4]; unsigned eo8r[2][4][4]; float gsb[2][4];
#define CMB_ISSUE(i, bf) do { const int t_ = m0 + (i); const v2u* xp_ = (const v2u*)(wsb(F, WS_XB) + (size_t)t_ * D) + F.lane; \
            _Pragma("unroll") for (int j = 0; j < 4; ++j) xbr[bf][j] = xp_[64 * j]; \
            const int wk_[4] = {__builtin_amdgcn_readlane(wall.x, (i)), __builtin_amdgcn_readlane(wall.y, (i)), __builtin_amdgcn_readlane(wall.z, (i)), __builtin_amdgcn_readlane(wall.w, (i))}; \
            gsb[bf][0] = __builtin_bit_cast(float, __builtin_amdgcn_readlane(gbx, (i))); gsb[bf][1] = __builtin_bit_cast(float, __builtin_amdgcn_readlane(gby, (i))); \
            gsb[bf][2] = __builtin_bit_cast(float, __builtin_amdgcn_readlane(gbz, (i))); gsb[bf][3] = __builtin_bit_cast(float, __builtin_amdgcn_readlane(gbw, (i))); \
            _Pragma("unroll") for (int k = 0; k < 4; ++k) { const int e_ = wk_[k] & 255, pos_ = wk_[k] >> 8; const size_t row_ = (size_t)F.MISC[MW_TSTART + e_] * 256 + pos_; \
                if (EO_FP8) { const unsigned* rq_ = (const unsigned*)((const unsigned char*)eo + row_ * 1024) + F.lane; _Pragma("unroll") for (int j = 0; j < 4; ++j) eo8r[bf][k][j] = rq_[64 * j]; } \
                else { const v2u* rp_ = (const v2u*)(eo + row_ * 1024) + F.lane; _Pragma("unroll") for (int j = 0; j < 4; ++j) eor[bf][k][j] = rp_[64 * j]; } } } while (0)
        CMB_ISSUE(0, 0);
#pragma unroll
        for (int i = 0; i < 16; ++i) { const int t = m0 + i; const int bf = i & 1;
            if (i + 1 < 16) { if (bf == 0) CMB_ISSUE(i + 1, 1); else CMB_ISSUE(i + 1, 0); }
            f32x4 v[4], acc[4];
#pragma unroll
            for (int j = 0; j < 4; ++j) { const v2u w = xbr[bf][j]; v[j] = (f32x4){bflo(w.x), bfhi(w.x), bflo(w.y), bfhi(w.y)}; acc[j] = (f32x4){0.f, 0.f, 0.f, 0.f}; }
#pragma unroll
            for (int k = 0; k < 4; ++k)
#pragma unroll
                for (int j = 0; j < 4; ++j) { if (EO_FP8) { const unsigned w = eo8r[bf][k][j]; const f32x2 lo = __builtin_amdgcn_cvt_pk_f32_fp8((int)w, false), hi = __builtin_amdgcn_cvt_pk_f32_fp8((int)w, true); acc[j] += (gsb[bf][k] * (1.0f / EO8_SCALE)) * (f32x4){lo[0], lo[1], hi[0], hi[1]}; }
                    else { const v2u w = eor[bf][k][j]; acc[j] += gsb[bf][k] * (f32x4){bflo(w.x), bfhi(w.x), bflo(w.y), bfhi(w.y)}; } }
#pragma unroll
            for (int j = 0; j < 4; ++j) v[j] = v[j] + ga[j] * acc[j];
            const float rs = row_rstd(v);
            if (l + 1 < NL) {
#pragma unroll
                for (int j = 0; j < 4; ++j) { v2u w; w.x = cvt_pk_bf16(v[j].x, v[j].y); w.y = cvt_pk_bf16(v[j].z, v[j].w); ((v2u*)(wsb(F, WS_XA) + (size_t)t * D))[64 * j + F.lane] = w; }
#pragma unroll
                for (int j = 0; j < 4; ++j) v[j] = v[j] * rs * A[j] + Bv[j];
                if (Z_FP8) store_row_fp8(F.ws + WS_H8 + (size_t)t * D, F.lane, v, H8_SCALE); else store_row_bf16(wsb(F, WS_H) + (size_t)t * D, F.lane, v);
            } else {
#pragma unroll
                for (int j = 0; j < 4; ++j) ((f32x4*)(F.out + (size_t)t * D))[64 * j + F.lane] = v[j] * rs * A[j];
            }
        }
#undef CMB_ISSUE
#else
        for (int i = 0; i < 16; ++i) { const int t = m0 + i;
            f32x4 v[4]; if (RES_BF16) load_row16_bf(wsb(F, WS_XB) + (size_t)t * D, F.lane, v); else load_row16(xb + (size_t)t * D, F.lane, v);
            f32x4 acc[4];
#pragma unroll
            for (int j = 0; j < 4; ++j) acc[j] = (f32x4){0.f, 0.f, 0.f, 0.f};
            const int4 w4 = *(const int4*)(wsi(F, WS_TOPI) + (size_t)t * 4); const f32x4 g4 = *(const f32x4*)(wsf(F, WS_GW) + (size_t)t * 4);
            const int ws_[4] = {w4.x, w4.y, w4.z, w4.w}; const float gs[4] = {g4.x, g4.y, g4.z, g4.w};
#pragma unroll
            for (int k = 0; k < 4; ++k) { const int e = ws_[k] & 255, pos = ws_[k] >> 8; const size_t row = (size_t)F.MISC[MW_TSTART + e] * 256 + pos;
                const v2u* rp = (const v2u*)(eo + row * 1024) + F.lane;
#pragma unroll
                for (int j = 0; j < 4; ++j) { const v2u w = rp[64 * j]; acc[j] += gs[k] * (f32x4){bflo(w.x), bfhi(w.x), bflo(w.y), bfhi(w.y)}; } }
#pragma unroll
            for (int j = 0; j < 4; ++j) v[j] = v[j] + ga[j] * acc[j];
            const float rs = row_rstd(v);
            if (l + 1 < NL) {
#pragma unroll
                for (int j = 0; j < 4; ++j) { if (RES_BF16) { v2u w; w.x = cvt_pk_bf16(v[j].x, v[j].y); w.y = cvt_pk_bf16(v[j].z, v[j].w); ((v2u*)(wsb(F, WS_XA) + (size_t)t * D))[64 * j + F.lane] = w; } else ((f32x4*)(wsf(F, WS_XA) + (size_t)t * D))[64 * j + F.lane] = v[j]; }
#pragma unroll
                for (int j = 0; j < 4; ++j) v[j] = v[j] * rs * A[j] + Bv[j];
                if (Z_FP8) store_row_fp8(F.ws + WS_H8 + (size_t)t * D, F.lane, v, H8_SCALE); else store_row_bf16(wsb(F, WS_H) + (size_t)t * D, F.lane, v);
            } else {
#pragma unroll
                for (int j = 0; j < 4; ++j) ((f32x4*)(F.out + (size_t)t * D))[64 * j + F.lane] = v[j] * rs * A[j];
            }
        }
#endif
    }
}

__device__ __forceinline__ float gelu_tanh(float x) { const float y = 0.7978845608028654f * (x + 0.044715f * x * x * x); const float t = 1.0f - 2.0f / (1.0f + __expf(2.0f * y)); return 0.5f * x * (1.0f + t); }
__device__ __forceinline__ void p_cmpfin(Frame& F, int l) {
    const int gw = F.vcu * NWAVES + F.wave, NGW = F.G * NWAVES;
    LAS float* w2l = (LAS float*)F.lds;
    LAS float* ab = (LAS float*)(F.lds + MISC_OFF + 1024 + F.wave * 1024);
    { const f32x4* src = (const f32x4*)(F.cmp_w2 + (size_t)l * 2 * 256 * 64); for (int i = F.tid; i < 2 * 256 * 64 / 4; i += NTHR) ((LAS f32x4*)w2l)[i] = src[i]; }
    __syncthreads();
    const float* ul = wsf(F, WS_UL);
    for (int it = gw; it < 2 * NB * 2 * NCMP; it += NGW) {
        const int kv = it / (NB * 2 * NCMP), r = it % (NB * 2 * NCMP), bg = r / NCMP, i = r % NCMP;
        const size_t ru = (size_t)kv * 4096 + bg * 512 + i; const float* posb = wsf(F, WS_POSB) + (size_t)(l * 2 + kv) * 256;
#pragma unroll
        for (int j = 0; j < 4; ++j) { const int n = F.lane + 64 * j; ab[n] = gelu_tanh(ul[ru * 512 + n] + ul[(ru + 1) * 512 + 256 + n] + posb[n]); }
        LDS_WAIT(); asm volatile("" ::: "memory");
        const LAS float* w2 = w2l + kv * 256 * 64 + F.lane; float o0 = 0.f, o1 = 0.f, o2 = 0.f, o3 = 0.f;
#pragma unroll 8
        for (int n = 0; n < 256; n += 4) { const f32x4 a = *(const LAS f32x4*)(ab + n); o0 += a[0] * w2[(n + 0) * 64]; o1 += a[1] * w2[(n + 1) * 64]; o2 += a[2] * w2[(n + 2) * 64]; o3 += a[3] * w2[(n + 3) * 64]; }
        wsb(F, WS_CMP)[((size_t)(kv * NB * 2 + bg) * 512 + i) * 64 + F.lane] = (bf16)f2bf((o0 + o1) + (o2 + o3));
        LDS_WAIT(); asm volatile("" ::: "memory");
    }
}

__device__ __forceinline__ int t5_bucket(int d) {
    if (d < 16) return d;
    return 16 + (d >= 19) + (d >= 21) + (d >= 24) + (d >= 27) + (d >= 31) + (d >= 35) + (d >= 40) + (d >= 46) + (d >= 52) + (d >= 59) + (d >= 67) + (d >= 77) + (d >= 87) + (d >= 99) + (d >= 113);
}
__device__ __forceinline__ void build_lut(Frame& F, LAS float* lut) {
    for (int i = F.tid; i < 16 * 128; i += NTHR) { const int h = i >> 7, d = i & 127; lut[i] = F.rel_tab[t5_bucket(d) * 16 + h]; }
    __syncthreads();
}
__device__ __forceinline__ float fdot2(unsigned a, unsigned b, float c) { return __builtin_amdgcn_fdot2_f32_bf16(__builtin_bit_cast(bf16v2, a), __builtin_bit_cast(bf16v2, b), c, false); }
__device__ __forceinline__ float dot64(const unsigned (&q)[32], const bf16* krow) {
    const v4u* kp = (const v4u*)krow; float s = 0.f;
#pragma unroll
    for (int i = 0; i < 8; ++i) { const v4u k = kp[i]; s = fdot2(q[4 * i], k.x, s); s = fdot2(q[4 * i + 1], k.y, s); s = fdot2(q[4 * i + 2], k.z, s); s = fdot2(q[4 * i + 3], k.w, s); }
    return s;
}
__device__ __forceinline__ void axpy64(float (&o)[64], float p, const bf16* vrow) {
    const v4u* vp = (const v4u*)vrow;
#pragma unroll
    for (int i = 0; i < 8; ++i) { const v4u v = vp[i];
        o[8 * i] += p * bflo(v.x); o[8 * i + 1] += p * bfhi(v.x); o[8 * i + 2] += p * bflo(v.y); o[8 * i + 3] += p * bfhi(v.y);
        o[8 * i + 4] += p * bflo(v.z); o[8 * i + 5] += p * bfhi(v.z); o[8 * i + 6] += p * bflo(v.w); o[8 * i + 7] += p * bfhi(v.w); }
}
__device__ __forceinline__ void attend_key(const unsigned (&q)[32], const bf16* krow, const bf16* vrow, float bias, float& m, float& l, float (&o)[64]) {
    const float s = dot64(q, krow) * 0.125f + bias;
    if (s > m) { const float a = __expf(m - s); l *= a;
#pragma unroll
        for (int d = 0; d < 64; ++d) o[d] *= a;
        m = s; }
    const float p = __expf(s - m); l += p; axpy64(o, p, vrow);
}
__device__ __forceinline__ void load_q(const bf16* qrow, unsigned (&q)[32]) { const v4u* p = (const v4u*)qrow;
#pragma unroll
    for (int i = 0; i < 8; ++i) { const v4u w = p[i]; q[4 * i] = w.x; q[4 * i + 1] = w.y; q[4 * i + 2] = w.z; q[4 * i + 3] = w.w; } }
__device__ __forceinline__ void store_o(bf16* orow, const float (&o)[64]) { v4u* p = (v4u*)orow;
#pragma unroll
    for (int i = 0; i < 8; ++i) { v4u w; w.x = cvt_pk_bf16(o[8 * i], o[8 * i + 1]); w.y = cvt_pk_bf16(o[8 * i + 2], o[8 * i + 3]); w.z = cvt_pk_bf16(o[8 * i + 4], o[8 * i + 5]); w.w = cvt_pk_bf16(o[8 * i + 6], o[8 * i + 7]); p[i] = w; } }

__device__ __forceinline__ void p_swa(Frame& F, int l) {
    LAS float* lut = (LAS float*)(F.lds + 98304);
    build_lut(F, lut);
    const bf16* KS = wsb(F, WS_KV) + 6 * KVB; const bf16* VS = wsb(F, WS_KV) + 7 * KVB;
    for (int it = blockIdx.x; it < NB * 2 * (S / 128); it += F.G) {
        const int b = it / (2 * (S / 128)), kvh = (it / (S / 128)) & 1, qb = it % (S / 128);
        const int qi = F.tid >> 2, hh = F.tid & 3, t = qb * 128 + qi, head = kvh * 4 + hh; const size_t tok = (size_t)b * S + t;
        unsigned q[32]; load_q(wsb(F, WS_QS) + tok * 512 + head * 64, q);
        float o[64];
#pragma unroll
        for (int d = 0; d < 64; ++d) o[d] = 0.f;
        float m = F.sinks[l * 8 + head], ls = 1.0f;
        const bf16* kb = KS + ((size_t)(b * 2 + kvh) * S) * 64; const bf16* vb = VS + ((size_t)(b * 2 + kvh) * S) * 64;
        const LAS float* lh = lut + (8 + head) * 128;
        for (int kk = 0; kk < 128; ++kk) { const int kpos = t - kk; if (kpos < 0) break; attend_key(q, kb + (size_t)kpos * 64, vb + (size_t)kpos * 64, lh[kk], m, ls, o); }
        const float inv = 1.0f / ls;
#pragma unroll
        for (int d = 0; d < 64; ++d) o[d] *= inv;
        store_o(wsb(F, WS_OS) + tok * 512 + head * 64, o);
    }
}

__device__ __forceinline__ void p_nsa(Frame& F, int l) {
    LAS float* lut = (LAS float*)(F.lds + 98304); LAS float* psl = (LAS float*)F.lds; LAS int* selidx = (LAS int*)(F.lds + 65536);
    build_lut(F, lut);
    const bf16* kvb = wsb(F, WS_KV);
    for (int it = blockIdx.x; it < NB * 2 * (S / 128); it += F.G) {
        const int b = it / (2 * (S / 128)), g = (it / (S / 128)) & 1, qb = it % (S / 128);
        const int qi = F.tid >> 2, hh = F.tid & 3, t = qb * 128 + qi, head = g * 4 + hh; const size_t tok = (size_t)b * S + t;
        __syncthreads();
        for (int i = F.tid; i < 128 * 128; i += NTHR) psl[i] = 0.f;
        __syncthreads();
        unsigned q[32]; load_q(wsb(F, WS_QN) + tok * 512 + head * 64, q);
        const bf16* gn = wsb(F, WS_GN) + tok * 32;
        float fin[64];
#pragma unroll
        for (int d = 0; d < 64; ++d) fin[d] = 0.f;
        const size_t bgS = (size_t)(b * 2 + g) * S * 64;
        {   const bf16* kc = wsb(F, WS_CMP) + (size_t)(b * 2 + g) * 512 * 64; const bf16* vc = kc + (size_t)NB * 2 * 512 * 64;
            const int nc = t >= 31 ? min((t - 31) / 16 + 1, NCMP) : 0;
            float m = -INFINITY, ls = 0.f;
            for (int i = 0; i < nc; ++i) { const float s = dot64(q, kc + (size_t)i * 64) * 0.125f; if (s > m) { ls *= __expf(m - s); m = s; } ls += __expf(s - m); }
            const float inv = nc > 0 ? 1.0f / ls : 0.f; const float gate = sigmoidf_(bflo((unsigned)gn[head]));
            for (int i = 0; i < nc; ++i) { const float s = dot64(q, kc + (size_t)i * 64) * 0.125f; const float p = __expf(s - m) * inv; axpy64(fin, p * gate, vc + (size_t)i * 64);
                float P = p + __shfl_xor(p, 1); P += __shfl_xor(P, 2);
                if (hh == 0) { const int j0 = i >> 2; LAS float* pr = psl + qi * 128;
                    if ((i & 3) == 0) { pr[j0] += P; if (j0 + 1 < 128) pr[j0 + 1] += P; } else if (j0 + 1 < 128) pr[j0 + 1] += 2.0f * P; } }
        }
        const int blk_t = t >> 6; const int nsel = blk_t < 16 ? blk_t + 1 : 16;
        LDS_WAIT(); asm volatile("" ::: "memory");
        if (hh == 0) { LAS int* si = selidx + qi * 16; LAS float* pr = psl + qi * 128;
            if (blk_t < 16) { for (int j = 0; j <= blk_t; ++j) si[j] = j; }
            else { si[0] = 0; si[1] = blk_t - 1; si[2] = blk_t;
                for (int r = 0; r < 13; ++r) { int best = 1; float bv = -1.0f;
                    for (int j = 1; j <= blk_t - 2; ++j) { const float v = pr[j]; if (v > bv) { bv = v; best = j; } }
                    si[3 + r] = best; pr[best] = -2.0f; } } }
        LDS_WAIT(); asm volatile("" ::: "memory");
        {   const bf16* kb = kvb + 2 * KVB + bgS; const bf16* vb = kvb + 3 * KVB + bgS; const LAS float* lh = lut + head * 128;
            float m = -INFINITY, ls = 0.f;
            for (int jj = 0; jj < nsel; ++jj) { const int j = selidx[qi * 16 + jj];
                for (int kk = 0; kk < 64; ++kk) { const int kpos = j * 64 + kk; if (kpos > t) break; const int dist = t - kpos;
                    const float s = dot64(q, kb + (size_t)kpos * 64) * 0.125f + lh[dist < 127 ? dist : 127]; if (s > m) { ls *= __expf(m - s); m = s; } ls += __expf(s - m); } }
            const float coef = sigmoidf_(bflo((unsigned)gn[8 + head])) / ls;
            for (int jj = 0; jj < nsel; ++jj) { const int j = selidx[qi * 16 + jj];
                for (int kk = 0; kk < 64; ++kk) { const int kpos = j * 64 + kk; if (kpos > t) break; const int dist = t - kpos;
                    const float s = dot64(q, kb + (size_t)kpos * 64) * 0.125f + lh[dist < 127 ? dist : 127]; axpy64(fin, __expf(s - m) * coef, vb + (size_t)kpos * 64); } }
        }
        {   const bf16* kb = kvb + 4 * KVB + bgS; const bf16* vb = kvb + 5 * KVB + bgS; const LAS float* lh = lut + head * 128;
            float m = -INFINITY, ls = 0.f;
            for (int kk = 0; kk < 512; ++kk) { const int kpos = t - kk; if (kpos < 0) break;
                const float s = dot64(q, kb + (size_t)kpos * 64) * 0.125f + lh[kk < 127 ? kk : 127]; if (s > m) { ls *= __expf(m - s); m = s; } ls += __expf(s - m); }
            const float coef = sigmoidf_(bflo((unsigned)gn[16 + head])) / ls;
            for (int kk = 0; kk < 512; ++kk) { const int kpos = t - kk; if (kpos < 0) break;
                const float s = dot64(q, kb + (size_t)kpos * 64) * 0.125f + lh[kk < 127 ? kk : 127]; axpy64(fin, __expf(s - m) * coef, vb + (size_t)kpos * 64); }
        }
        store_o(wsb(F, WS_ON) + tok * 512 + head * 64, fin);
    }
}

typedef short v4i16_t __attribute__((ext_vector_type(4)));
constexpr int KT_STRIDE = 144;
constexpr int KT_BYTES = 64 * KT_STRIDE;
__device__ __forceinline__ v4i16_t vtr(const LAS unsigned char* p) { return __builtin_amdgcn_ds_read_tr16_b64_v4i16((LAS v4i16_t*)p); }
__device__ __forceinline__ f32x4 mfma16(bf16x8 a, bf16x8 b, f32x4 c) { return __builtin_amdgcn_mfma_f32_16x16x32_bf16(a, b, c, 0, 0, 0); }
struct KVRegs { v4u k, v; };
__device__ __forceinline__ void kv_fetch(KVRegs& r, const bf16* kg, const bf16* vg, int row0, int tid) { const size_t o = (size_t)(row0 + (tid >> 3)) * 64 + (tid & 7) * 8; r.k = *(const v4u*)(kg + o); r.v = *(const v4u*)(vg + o); }
__device__ __forceinline__ void kv_put(const KVRegs& r, LAS unsigned char* kt, LAS unsigned char* vt, int tid) { const int o = (tid >> 3) * KT_STRIDE + (tid & 7) * 16; *(LAS v4u*)(kt + o) = r.k; *(LAS v4u*)(vt + o) = r.v; }
__device__ __forceinline__ void load_qfrag(const bf16* qrow, int kg, bf16x8 (&qf)[2]) {
#pragma unroll
    for (int hf = 0; hf < 2; ++hf) { const v4u w = *(const v4u*)(qrow + 32 * hf + 8 * kg); v4u o;
        constexpr float QS = 0.125f * 1.4426950408889634f;
        o.x = cvt_pk_bf16(bflo(w.x) * QS, bfhi(w.x) * QS); o.y = cvt_pk_bf16(bflo(w.y) * QS, bfhi(w.y) * QS);
        o.z = cvt_pk_bf16(bflo(w.z) * QS, bfhi(w.z) * QS); o.w = cvt_pk_bf16(bflo(w.w) * QS, bfhi(w.w) * QS);
        qf[hf] = __builtin_bit_cast(bf16x8, o); } }
__device__ __forceinline__ void qk_step(const LAS unsigned char* kt, int r0, int lane, const bf16x8 (&qf)[2], f32x4& s0, f32x4& s1) {
    const LAS unsigned char* kp = kt + (r0 + (lane & 15)) * KT_STRIDE + (lane >> 4) * 16;
    const bf16x8 k00 = *(const LAS bf16x8*)kp, k01 = *(const LAS bf16x8*)(kp + 64), k10 = *(const LAS bf16x8*)(kp + 16 * KT_STRIDE), k11 = *(const LAS bf16x8*)(kp + 16 * KT_STRIDE + 64);
    const f32x4 z = {0.f, 0.f, 0.f, 0.f};
    s0 = mfma16(k00, qf[0], z); s0 = mfma16(k01, qf[1], s0);
    s1 = mfma16(k10, qf[0], z); s1 = mfma16(k11, qf[1], s1);
}
__device__ __forceinline__ void pv_step(const LAS unsigned char* vt, int r0, int lane, const f32x4& p0, const f32x4& p1, f32x4 (&o)[4]) {
    v4u pw; pw.x = cvt_pk_bf16(p0[0], p0[1]); pw.y = cvt_pk_bf16(p0[2], p0[3]); pw.z = cvt_pk_bf16(p1[0], p1[1]); pw.w = cvt_pk_bf16(p1[2], p1[3]);
    const bf16x8 pf = __builtin_bit_cast(bf16x8, pw);
    const LAS unsigned char* vp = vt + (r0 + 4 * (lane >> 4) + ((lane & 15) >> 2)) * KT_STRIDE + (lane & 3) * 8;
#pragma unroll
    for (int dt = 0; dt < 4; ++dt) { const v4i16_t a = vtr(vp + dt * 32), b = vtr(vp + 16 * KT_STRIDE + dt * 32);
        bf16x8 vf; vf[0] = a[0]; vf[1] = a[1]; vf[2] = a[2]; vf[3] = a[3]; vf[4] = b[0]; vf[5] = b[1]; vf[6] = b[2]; vf[7] = b[3];
        o[dt] = mfma16(vf, pf, o[dt]); }
}
__device__ __forceinline__ void load_kfrag(const LAS unsigned char* kt, int r0, int lane, bf16x8 (&kf)[4]) {
    const LAS unsigned char* kp = kt + (r0 + (lane & 15)) * KT_STRIDE + (lane >> 4) * 16;
    kf[0] = *(const LAS bf16x8*)kp; kf[1] = *(const LAS bf16x8*)(kp + 64); kf[2] = *(const LAS bf16x8*)(kp + 16 * KT_STRIDE); kf[3] = *(const LAS bf16x8*)(kp + 16 * KT_STRIDE + 64);
}
__device__ __forceinline__ void qk_mma(const bf16x8 (&kf)[4], const bf16x8 (&qf)[2], f32x4& s0, f32x4& s1, float c0 = 0.f) {
    const f32x4 z = {c0, c0, c0, c0};
    __builtin_amdgcn_s_setprio(1);
    s0 = mfma16(kf[0], qf[0], z); s1 = mfma16(kf[2], qf[0], z); s0 = mfma16(kf[1], qf[1], s0); s1 = mfma16(kf[3], qf[1], s1);
    __builtin_amdgcn_s_setprio(0);
}
__device__ __forceinline__ void load_vfrag(const LAS unsigned char* vt, int r0, int lane, bf16x8 (&vf)[4]) {
    const LAS unsigned char* vp = vt + (r0 + 4 * (lane >> 4) + ((lane & 15) >> 2)) * KT_STRIDE + (lane & 3) * 8;
#pragma unroll
    for (int dt = 0; dt < 4; ++dt) { const v4i16_t a = vtr(vp + dt * 32), b = vtr(vp + 16 * KT_STRIDE + dt * 32);
        vf[dt][0] = a[0]; vf[dt][1] = a[1]; vf[dt][2] = a[2]; vf[dt][3] = a[3]; vf[dt][4] = b[0]; vf[dt][5] = b[1]; vf[dt][6] = b[2]; vf[dt][7] = b[3]; }
}
__device__ __forceinline__ void pv_mma(const bf16x8 (&vf)[4], const f32x4& p0, const f32x4& p1, f32x4 (&o)[4]) {
    v4u pw; pw.x = cvt_pk_bf16(p0[0], p0[1]); pw.y = cvt_pk_bf16(p0[2], p0[3]); pw.z = cvt_pk_bf16(p1[0], p1[1]); pw.w = cvt_pk_bf16(p1[2], p1[3]);
    const bf16x8 pf = __builtin_bit_cast(bf16x8, pw);
    __builtin_amdgcn_s_setprio(1);
#pragma unroll
    for (int dt = 0; dt < 4; ++dt) o[dt] = mfma16(vf[dt], pf, o[dt]);
    __builtin_amdgcn_s_setprio(0);
}
constexpr float LOG2E = 1.4426950408889634f;
constexpr float M_INIT = -1.0e30f;
struct RowState { float m, l; f32x4 o[4]; };
__device__ __forceinline__ void rs_init(RowState& r, float m0, float l0) { r.m = m0; r.l = l0;
#pragma unroll
    for (int dt = 0; dt < 4; ++dt) r.o[dt] = (f32x4){0.f, 0.f, 0.f, 0.f}; }
__device__ __forceinline__ float grp_max(float x) { x = fmaxf(x, __shfl_xor(x, 16)); return fmaxf(x, __shfl_xor(x, 32)); }
__device__ __forceinline__ float grp_sum(float x) { x += __shfl_xor(x, 16); return x + __shfl_xor(x, 32); }
__device__ __forceinline__ float max8(const f32x4& v0, const f32x4& v1) { return fmaxf(fmaxf(fmaxf(v0[0], v0[1]), fmaxf(v0[2], v0[3])), fmaxf(fmaxf(v1[0], v1[1]), fmaxf(v1[2], v1[3]))); }
__device__ __forceinline__ int fbits(float x) { return __builtin_bit_cast(int, x); }
__device__ __forceinline__ int imax8(const f32x4& a, const f32x4& b) {
    const float a0 = a[0], a1 = a[1], a2 = a[2], a3 = a[3], b0 = b[0], b1 = b[1], b2 = b[2], b3 = b[3];
    const int i0 = max(max(fbits(a0), fbits(a1)), fbits(a2)), i1 = max(max(fbits(a3), fbits(b0)), fbits(b1));
    return max(max(i0, i1), max(fbits(b2), fbits(b3)));
}
__device__ __forceinline__ void softmax_step(RowState& r, f32x4& v0, f32x4& v1) {
    const float lm = max8(v0, v1);
    if (__any(lm > r.m + 12.0f)) {
        const float tm = grp_max(lm); const bool need = tm > r.m + 12.0f;
        const float mn = need ? tm : r.m; const float f = need ? __builtin_amdgcn_exp2f(r.m - mn) : 1.0f; r.m = mn; r.l *= f;
#pragma unroll
        for (int dt = 0; dt < 4; ++dt) r.o[dt] = r.o[dt] * f; }
    v0 = v0 - r.m; v1 = v1 - r.m;
#pragma unroll
    for (int i = 0; i < 4; ++i) { v0[i] = __builtin_amdgcn_exp2f(v0[i]); v1[i] = __builtin_amdgcn_exp2f(v1[i]); }
    const f32x4 sv = v0 + v1; r.l += (sv[0] + sv[1]) + (sv[2] + sv[3]);
}
__device__ __forceinline__ void stats_step(float& m, float& l, const f32x4& v0, const f32x4& v1) {
    const float lm = max8(v0, v1);
    if (__any(lm > m + 12.0f)) { const float tm = grp_max(lm); const bool need = tm > m + 12.0f; const float mn = need ? tm : m; l *= need ? __builtin_amdgcn_exp2f(m - mn) : 1.0f; m = mn; }
    const f32x4 a = v0 - m, c = v1 - m; float ps = 0.f;
#pragma unroll
    for (int i = 0; i < 4; ++i) ps += __builtin_amdgcn_exp2f(a[i]) + __builtin_amdgcn_exp2f(c[i]);
    l += ps;
}
__device__ __forceinline__ void softmax_fast(RowState& r, const bf16x8 (&kf)[4], const bf16x8 (&qf)[2], float bsel, f32x4& v0, f32x4& v1) {
    qk_mma(kf, qf, v0, v1, bsel - r.m);
    const int im = imax8(v0, v1);
    if (__any(im > 0x41400000  )) {
        qk_mma(kf, qf, v0, v1, bsel);
        const float tm = grp_max(max8(v0, v1)); const bool need = tm > r.m + 12.0f;
        const float mn = need ? tm : r.m; const float f = need ? __builtin_amdgcn_exp2f(r.m - mn) : 1.0f; r.m = mn; r.l *= f;
#pragma unroll
        for (int dt = 0; dt < 4; ++dt) r.o[dt] = r.o[dt] * f;
        v0 = v0 - r.m; v1 = v1 - r.m; }
#pragma unroll
    for (int i = 0; i < 4; ++i) { v0[i] = __builtin_amdgcn_exp2f(v0[i]); v1[i] = __builtin_amdgcn_exp2f(v1[i]); }
    const f32x4 sv = v0 + v1; r.l += (sv[0] + sv[1]) + (sv[2] + sv[3]);
}
__device__ __forceinline__ void bias_general(f32x4& v0, f32x4& v1, int d0, int W, bool ok, const LAS float* lh) {
#pragma unroll
    for (int i = 0; i < 4; ++i) { const int da = d0 - i, db = d0 - 16 - i;
        v0[i] = (ok && da >= 0 && da < W) ? v0[i] + lh[da < 127 ? da : 127] : -INFINITY;
        v1[i] = (ok && db >= 0 && db < W) ? v1[i] + lh[db < 127 ? db : 127] : -INFINITY; }
}
__device__ __forceinline__ void bias_general2(f32x4& v0, f32x4& v1, int d0, int W, bool ok, const LAS float* lh) {
#pragma unroll
    for (int i = 0; i < 4; ++i) { const int da = d0 - i, db = d0 - 16 - i;
        const float ba = lh[min(max(da, 0), 127)], bb = lh[min(max(db, 0), 127)];
        v0[i] += (ok && da >= 0 && da < W) ? ba : -INFINITY;
        v1[i] += (ok && db >= 0 && db < W) ? bb : -INFINITY; }
}
__device__ __forceinline__ void build_lut2(Frame& F, LAS float* lut) {
    for (int i = F.tid; i < 16 * 128; i += NTHR) { const int h = i >> 7, d = i & 127; lut[i] = F.rel_tab[t5_bucket(d) * 16 + h] * LOG2E; }
    __syncthreads();
}
__device__ __forceinline__ void store_orow8(unsigned char* op, const f32x4 (&o)[4], float sc) {
#pragma unroll
    for (int dt = 0; dt < 4; ++dt) { const f32x4 x = o[dt] * sc; *(unsigned*)(op + 16 * dt) = pack_fp8x4(x[0], x[1], x[2], x[3]); }
}
__device__ __forceinline__ void store_orow(bf16* op, const f32x4 (&o)[4], float sc) {
#pragma unroll
    for (int dt = 0; dt < 4; ++dt) { const f32x4 x = o[dt] * sc; v2u w; w.x = cvt_pk_bf16(x[0], x[1]); w.y = cvt_pk_bf16(x[2], x[3]); *(v2u*)(op + 16 * dt) = w; }
}

__device__ __forceinline__ void p_swa2(Frame& F, int l) {
    LAS float* lut = (LAS float*)(F.lds + 98304);
    build_lut2(F, lut);
    LAS unsigned char* kt = F.lds; LAS unsigned char* vt = F.lds + 2 * KT_BYTES;
    const bf16* KS = wsb(F, WS_KV) + 6 * KVB; const bf16* VS = wsb(F, WS_KV) + 7 * KVB;
    const int lane = F.lane, kg = lane >> 4, rl = lane & 15, hh = rl & 3;
    const bool skew = (F.G == 256); const int nmine = !skew ? (NB * 2 * (S / 64) - (int)blockIdx.x + F.G - 1) / F.G : (F.vcu < 64 ? 2 : (F.vcu - 64 < 128 ? 5 : 4));
    for (int ii = 0; ii < nmine; ++ii) {
        const int it = !skew ? (int)blockIdx.x + ii * F.G : (F.vcu < 64 ? 896 + 2 * F.vcu + ii : (ii < 4 ? (F.vcu - 64) + 192 * ii : 768 + (F.vcu - 64)));
        const int b = it / (2 * (S / 64)), kvh = (it / (S / 64)) & 1, qb = it % (S / 64), s0 = qb * 64;
        const int head = kvh * 4 + hh; const LAS float* lh = lut + (8 + head) * 128;
        const bf16* kb = KS + ((size_t)(b * 2 + kvh) * S) * 64; const bf16* vb = VS + ((size_t)(b * 2 + kvh) * S) * 64;
        bf16x8 qf[2][2]; RowState rs[2]; int tl[2];
#pragma unroll
        for (int rt = 0; rt < 2; ++rt) { tl[rt] = s0 + 8 * F.wave + 4 * rt + (rl >> 2);
            load_qfrag(wsb(F, WS_QS) + ((size_t)b * S + tl[rt]) * 512 + head * 64, kg, qf[rt]);
            rs_init(rs[rt], F.sinks[l * 8 + head] * LOG2E, kg == 0 ? 1.0f : 0.f); }
        const int jt0 = qb >= 2 ? qb - 2 : 0, ntile = qb - jt0 + 1;
        KVRegs kr; kv_fetch(kr, kb, vb, jt0 * 64, F.tid);
        for (int ti = 0; ti < ntile; ++ti) {
            const int buf = ti & 1; kv_put(kr, kt + buf * KT_BYTES, vt + buf * KT_BYTES, F.tid);
            __syncthreads();
            if (ti + 1 < ntile) kv_fetch(kr, kb, vb, (jt0 + ti + 1) * 64, F.tid);
            const int kp0 = (jt0 + ti) * 64;
#pragma unroll 1
            for (int ks = 0; ks < 2; ++ks) { bf16x8 kf[4], vf[4]; load_kfrag(kt + buf * KT_BYTES, 32 * ks, lane, kf); load_vfrag(vt + buf * KT_BYTES, 32 * ks, lane, vf);
#pragma unroll
                for (int rt = 0; rt < 2; ++rt) { f32x4 v0, v1; qk_mma(kf, qf[rt], v0, v1);
                    bias_general2(v0, v1, tl[rt] - (kp0 + 32 * ks + 4 * kg), 128, true, lh);
                    softmax_step(rs[rt], v0, v1);
                    pv_mma(vf, v0, v1, rs[rt].o); } }
        }
#pragma unroll
        for (int rt = 0; rt < 2; ++rt) { if (MIX_FP8) store_orow8(F.ws + WS_ON + ((size_t)b * S + tl[rt]) * 1024 + 512 + head * 64 + 4 * kg, rs[rt].o, O8_SCALE / grp_sum(rs[rt].l));
            else store_orow(wsb(F, WS_OS) + ((size_t)b * S + tl[rt]) * 512 + head * 64 + 4 * kg, rs[rt].o, 1.0f / grp_sum(rs[rt].l)); }
        __syncthreads();
    }
}

constexpr int CONV_RUNS = NE * (32 * 16 + 16 * 16);
__device__ __forceinline__ void conv_addr(const Frame& F, int l, int R, int k8, const float*& src, size_t& ldn, unsigned char*& dst) {
    const int e = R / 768, r = R - e * 768; const size_t le = (size_t)l * NE + e;
    if (r < 512) { const int n64 = r >> 4, k64 = r & 15; ldn = 2048; src = F.w_up + (le * 1024 + k64 * 64 + 8 * k8) * 2048 + n64 * 64; dst = F.ws + WS_WUP + (le * 2048 + n64 * 64) * 1024 + k64 * 64 + 8 * k8; }
    else { const int q = r - 512, n64 = q >> 4, k64 = q & 15; ldn = 1024; src = F.w_down + (le * 1024 + k64 * 64 + 8 * k8) * 1024 + n64 * 64; dst = F.ws + WS_WDN + (le * 1024 + n64 * 64) * 1024 + k64 * 64 + 8 * k8; }
}
__device__ __forceinline__ void conv_tick(const Frame& F, int l, int lane, int gw, int NGW, int nsteps, int& cs, bool& pend, float (&cv)[8], LAS unsigned char* stg) {
    if (pend) { const int sp = cs - 1, k8 = sp & 7;
        v2u w; w.x = pack_fp8x4(cv[0] * W8_SCALE, cv[1] * W8_SCALE, cv[2] * W8_SCALE, cv[3] * W8_SCALE); w.y = pack_fp8x4(cv[4] * W8_SCALE, cv[5] * W8_SCALE, cv[6] * W8_SCALE, cv[7] * W8_SCALE);
        *(LAS v2u*)(stg + lane * 80 + k8 * 8) = w;
        if (k8 == 7) { const float* src; size_t ldn; unsigned char* dst; conv_addr(F, l, gw + (sp >> 3) * NGW, 0, src, ldn, dst);
#pragma unroll
            for (int i = 0; i < 4; ++i) { const int n = 16 * i + (lane >> 2); const v4u x = *(const LAS v4u*)(stg + n * 80 + (lane & 3) * 16); *(v4u*)(dst + (size_t)n * 1024 + (lane & 3) * 16) = x; } }
        pend = false; }
    if (cs < nsteps) { const float* src; size_t ldn; unsigned char* dst; conv_addr(F, l, gw + (cs >> 3) * NGW, cs & 7, src, ldn, dst);
#pragma unroll
        for (int i = 0; i < 8; ++i) cv[i] = src[(size_t)i * ldn + lane];
        pend = true; ++cs; }
}

__device__ __forceinline__ int next_bit(unsigned long long lo, unsigned long long hi, int j) {
    int k = j + 1;
    if (k < 64) { const unsigned long long m = lo >> k; if (m) return k + __builtin_ctzll(m); k = 64; }
    if (k < 128) { const unsigned long long m = hi >> (k - 64); if (m) return k + __builtin_ctzll(m); }
    return 128;
}
__device__ __forceinline__ void setbit128(unsigned long long& lo, unsigned long long& hi, int idx) { if (idx < 64) lo |= 1ull << idx; else hi |= 1ull << (idx - 64); }
__device__ __forceinline__ unsigned getbit128(unsigned long long lo, unsigned long long hi, int idx) { return (unsigned)(((idx < 64 ? lo : hi) >> (idx & 63)) & 1ull); }
__device__ __forceinline__ unsigned long long rfl64(unsigned lo, unsigned hi) { return (unsigned long long)(unsigned)__builtin_amdgcn_readfirstlane((int)lo) | ((unsigned long long)(unsigned)__builtin_amdgcn_readfirstlane((int)hi) << 32); }

__device__ __forceinline__ void p_nsa2(Frame& F, int l, int mode = 0) {
    LAS float* lut = (LAS float*)(F.lds + 98304);
    build_lut2(F, lut);
    LAS unsigned char* kt = F.lds; LAS unsigned char* vt = F.lds + 2 * KT_BYTES;
    LAS float* psl = (LAS float*)(F.lds + 4 * KT_BYTES);
    volatile LAS unsigned* selm = (volatile LAS unsigned*)(F.lds + 94208);
    volatile LAS unsigned* unim = selm + 256;
    const bf16* kvb = wsb(F, WS_KV);
    const int cgw = F.vcu * NWAVES + F.wave, cNGW = F.G * NWAVES; const int cnsteps = (BG_CONV && mode == 0) ? 8 * ((CONV_RUNS - cgw + cNGW - 1) / cNGW) : 0; int ccs = 0; bool cpend = false; float ccv[8];
    LAS unsigned char* const cstg = F.lds + (F.wave < 4 ? 73728 + F.wave * 5120 : 106496 + (F.wave - 4) * 5120);
    const bool fast = (F.G == 256);
    const int nit = fast ? 4 : (NB * 2 * 128 - (int)blockIdx.x + F.G - 1) / F.G;
    for (int ii = 0; ii < nit; ++ii) {
        int it;
        if (fast) { const int x = F.vcu >> 5, c = F.vcu & 31; const int qbx = ii == 0 ? c : ii == 1 ? 63 - c : ii == 2 ? 64 + c : 127 - c; it = x * 128 + qbx; }
        else it = blockIdx.x + ii * F.G;
        const int b = it >> 8, g = (it >> 7) & 1, qb = it & 127, s0 = qb * 64;
        const size_t bgS = (size_t)(b * 2 + g) * S * 64;
        int lane = F.tid & 63; asm volatile("" : "+v"(lane));
        const int kg = lane >> 4, rl = lane & 15, hh = rl & 3, head = g * 4 + hh;
        __syncthreads();
        if (F.tid < 260) selm[F.tid] = 0u;
        bf16x8 qf[2][2]; int tl[2], qi[2]; v2u fin[2][4];
#pragma unroll
        for (int rt = 0; rt < 2; ++rt) { qi[rt] = 8 * F.wave + 4 * rt + (rl >> 2); tl[rt] = s0 + qi[rt];
            load_qfrag(wsb(F, WS_QN) + ((size_t)b * S + tl[rt]) * 512 + head * 64, kg, qf[rt]);
#pragma unroll
            for (int dt = 0; dt < 4; ++dt) { fin[rt][dt].x = 0u; fin[rt][dt].y = 0u; } }
#define NSA_GATE(rt, br) sigmoidf_(bflo((unsigned)(wsb(F, WS_GN) + ((size_t)b * S + tl[rt]) * 32)[(br) * 8 + head]))
#define NSA_FIN_ADD(rt, coef) do { _Pragma("unroll") for (int dt = 0; dt < 4; ++dt) { const f32x4 x = rs[rt].o[dt] * (coef); \
            fin[rt][dt].x = cvt_pk_bf16(bflo(fin[rt][dt].x) + x[0], bfhi(fin[rt][dt].x) + x[1]); fin[rt][dt].y = cvt_pk_bf16(bflo(fin[rt][dt].y) + x[2], bfhi(fin[rt][dt].y) + x[3]); } } while (0)
        __syncthreads();
        if (mode != 2) {   const bf16* kc = wsb(F, WS_CMP) + (size_t)(b * 2 + g) * 512 * 64; const bf16* vc = kc + (size_t)NB * 2 * 512 * 64;
            const int tmax = s0 + 63, ncmax = tmax >= 31 ? min((tmax - 31) / 16 + 1, NCMP) : 0, nct = (ncmax + 63) >> 6;
            const int tw0 = s0 + 8 * F.wave, ncw = tw0 >= 31 ? min((tw0 - 31) / 16 + 1, NCMP) : 0;
            int ncl[2]; float cm[2], cl[2];
#pragma unroll
            for (int rt = 0; rt < 2; ++rt) { ncl[rt] = tl[rt] >= 31 ? min((tl[rt] - 31) / 16 + 1, NCMP) : 0; cm[rt] = M_INIT; cl[rt] = 0.f; }
#pragma unroll
            for (int pass = 0; pass < 2; ++pass) {
                RowState rs[2];
                if (pass == 1) {
#pragma unroll
                    for (int rt = 0; rt < 2; ++rt) { const float lt = grp_sum(cl[rt]); cl[rt] = lt > 0.f ? 1.0f / lt : 0.f; rs_init(rs[rt], 0.f, 0.f); } }
                if (nct > 0) {
                    KVRegs kr; kv_fetch(kr, kc, vc, 0, F.tid);
                    for (int ct = 0; ct < nct; ++ct) {
                        const int buf = ct & 1; kv_put(kr, kt + buf * KT_BYTES, vt + buf * KT_BYTES, F.tid);
                        __syncthreads();
                        if (ct + 1 < nct) kv_fetch(kr, kc, vc, (ct + 1) * 64, F.tid);
                        const bool full = (ct * 64 + 64 <= ncw);
#pragma unroll 1
                        for (int ks = 0; ks < 2; ++ks) { bf16x8 kf[4], vf[4]; load_kfrag(kt + buf * KT_BYTES, 32 * ks, lane, kf); if (pass == 1) load_vfrag(vt + buf * KT_BYTES, 32 * ks, lane, vf);
#pragma unroll
                            for (int rt = 0; rt < 2; ++rt) { f32x4 v0, v1; qk_mma(kf, qf[rt], v0, v1);
                                const int i0 = ct * 64 + 32 * ks + 4 * kg;
                                if (!full) {
#pragma unroll
                                    for (int i = 0; i < 4; ++i) { v0[i] = (i0 + i < ncl[rt]) ? v0[i] : -INFINITY; v1[i] = (i0 + 16 + i < ncl[rt]) ? v1[i] : -INFINITY; } }
                                if (pass == 0) stats_step(cm[rt], cl[rt], v0, v1);
                                else {
#pragma unroll
                                    for (int i = 0; i < 4; ++i) { v0[i] = __builtin_amdgcn_exp2f(v0[i] - cm[rt]) * cl[rt]; v1[i] = __builtin_amdgcn_exp2f(v1[i] - cm[rt]) * cl[rt]; }
                                    pv_mma(vf, v0, v1, rs[rt].o);
                                    const float a0s = quad_sum(v0[0]), a1s = quad_sum(v0[0] + 2.0f * (v0[1] + v0[2] + v0[3])), c0s = quad_sum(v1[0]), c1s = quad_sum(v1[0] + 2.0f * (v1[1] + v1[2] + v1[3]));
                                    if (hh == 0) { LAS _Float16* pr = (LAS _Float16*)psl + qi[rt] * 136; const int B0 = (i0 >> 2);
                                        pr[B0] = (_Float16)a0s; pr[64 * 136 + B0 + 1] = (_Float16)a1s; pr[B0 + 4] = (_Float16)c0s; pr[64 * 136 + B0 + 5] = (_Float16)c1s; }
                                } } }
                    }
                    __syncthreads();
                }
                if (pass == 1) {
#pragma unroll
                    for (int rt = 0; rt < 2; ++rt) { const float g0 = NSA_GATE(rt, 0); NSA_FIN_ADD(rt, g0); } }
            }
        }
        __syncthreads();
        if (mode != 2) {   int tz = threadIdx.x; asm volatile("" : "+v"(tz));
            const int q = tz >> 3, part = tz & 7; unsigned long long mlo = 0ull, mhi = 0ull;
            if (qb < 16) { mlo = (1ull << (qb + 1)) - 1ull; }
            else {
                float vals[16];
#pragma unroll
                for (int i = 0; i < 16; ++i) { const int j = part * 16 + i; const LAS _Float16* ph = (const LAS _Float16*)psl + q * 136 + j; vals[i] = (j >= 1 && j <= qb - 2) ? (float)ph[0] + (float)ph[64 * 136] : -1.0f; }
                mlo |= 1ull; setbit128(mlo, mhi, qb - 1); setbit128(mlo, mhi, qb);
                for (int r = 0; r < 13; ++r) { float bv = -1.0f; int bi = 1 << 20;
#pragma unroll
                    for (int i = 0; i < 16; ++i) { if (vals[i] > bv) { bv = vals[i]; bi = part * 16 + i; } }
#pragma unroll
                    for (int o = 0; o < 3; ++o) { const float ov = o == 0 ? dpp_x1(bv) : o == 1 ? dpp_x2(bv) : dpp_hm(bv); const int oi = o == 0 ? dpp_x1i(bi) : o == 1 ? dpp_x2i(bi) : dpp_hmi(bi); if (ov > bv || (ov == bv && oi < bi)) { bv = ov; bi = oi; } }
#pragma unroll
                    for (int i = 0; i < 16; ++i) if (part * 16 + i == bi) vals[i] = -2.0f;
                    setbit128(mlo, mhi, bi); }
            }
            if (part == 0) { selm[q * 4 + 0] = (unsigned)mlo; selm[q * 4 + 1] = (unsigned)(mlo >> 32); selm[q * 4 + 2] = (unsigned)mhi; selm[q * 4 + 3] = (unsigned)(mhi >> 32);
                atomicOr((unsigned*)&unim[0], (unsigned)mlo); atomicOr((unsigned*)&unim[1], (unsigned)(mlo >> 32)); atomicOr((unsigned*)&unim[2], (unsigned)mhi); atomicOr((unsigned*)&unim[3], (unsigned)(mhi >> 32)); }
        }
        __syncthreads();
        if (mode == 1) continue;
        if (mode != 2) {   unsigned long long rlo[2], rhi[2];
#pragma unroll
            for (int rt = 0; rt < 2; ++rt) { unsigned w0 = 0u, w1 = 0u, w2 = 0u, w3 = 0u; const int qb0 = 8 * F.wave + 4 * rt;
#pragma unroll
                for (int k = 0; k < 4; ++k) { w0 |= selm[(qb0 + k) * 4 + 0]; w1 |= selm[(qb0 + k) * 4 + 1]; w2 |= selm[(qb0 + k) * 4 + 2]; w3 |= selm[(qb0 + k) * 4 + 3]; }
                rlo[rt] = rfl64(w0, w1); rhi[rt] = rfl64(w2, w3); }
            const unsigned long long ulo = rfl64(unim[0], unim[1]), uhi = rfl64(unim[2], unim[3]);
            const LAS float* lh = lut + head * 128; const float bfar = lh[127];
            RowState rs[2]; rs_init(rs[0], M_INIT, 0.f); rs_init(rs[1], M_INIT, 0.f);
            const bf16* kb = kvb + 2 * KVB + bgS; const bf16* vb = kvb + 3 * KVB + bgS;
            LAS unsigned char* const kt2 = F.lds; LAS unsigned char* const vt2 = F.lds + 4 * KT_BYTES;
            int ja = next_bit(ulo, uhi, -1), jb = next_bit(ulo, uhi, ja), ti = 0; KVRegs kra, krb;
            if (ja <= qb) kv_fetch(kra, kb, vb, ja * 64, F.tid);
            if (jb <= qb) kv_fetch(krb, kb, vb, jb * 64, F.tid);
            while (ja <= qb) {
                const int p = (ti & 1) * 2;
                kv_put(kra, kt2 + p * KT_BYTES, vt2 + p * KT_BYTES, F.tid);
                if (jb <= qb) kv_put(krb, kt2 + (p + 1) * KT_BYTES, vt2 + (p + 1) * KT_BYTES, F.tid);
                __syncthreads();
                const int na = next_bit(ulo, uhi, jb), nb = next_bit(ulo, uhi, na);
                if (na <= qb) kv_fetch(kra, kb, vb, na * 64, F.tid);
                if (nb <= qb) kv_fetch(krb, kb, vb, nb * 64, F.tid);
#pragma unroll 1
                for (int h = 0; h < 2; ++h) {
                    const int j = h ? jb : ja; if (j > qb) break;
                    const LAS unsigned char* ktb = kt2 + (p + h) * KT_BYTES; const LAS unsigned char* vtb = vt2 + (p + h) * KT_BYTES;
                    const bool act0 = getbit128(rlo[0], rhi[0], j) != 0u, act1 = getbit128(rlo[1], rhi[1], j) != 0u;
                    if (BG_CONV && !(act0 && act1)) conv_tick(F, l, lane, cgw, cNGW, cnsteps, ccs, cpend, ccv, cstg);
                    if (act0 || act1) {
                        const bool far = (j + 3 <= qb);
                        bool sel[2]; float bsel[2];
#pragma unroll
                        for (int rt = 0; rt < 2; ++rt) { sel[rt] = ((((const LAS unsigned*)selm)[qi[rt] * 4 + (j >> 5)] >> (j & 31)) & 1u) != 0u; bsel[rt] = sel[rt] ? bfar : -INFINITY; }
#pragma unroll
                        for (int ks = 0; ks < 2; ++ks) { bf16x8 kf[4], vf[4]; load_kfrag(ktb, 32 * ks, lane, kf); load_vfrag(vtb, 32 * ks, lane, vf);
#pragma unroll
                            for (int rt = 0; rt < 2; ++rt) if (rt == 0 ? act0 : act1) { f32x4 v0, v1;
                                if (far) softmax_fast(rs[rt], kf, qf[rt], bsel[rt], v0, v1);
                                else { qk_mma(kf, qf[rt], v0, v1); bias_general2(v0, v1, tl[rt] - (j * 64 + 32 * ks + 4 * kg), 1 << 30, sel[rt], lh); softmax_step(rs[rt], v0, v1); }
                                pv_mma(vf, v0, v1, rs[rt].o); } }
                    }
                }
                ja = na; jb = nb; ++ti;
            }
#pragma unroll
            for (int rt = 0; rt < 2; ++rt) { const float lt = grp_sum(rs[rt].l); const float coef = lt > 0.f ? NSA_GATE(rt, 1) / lt : 0.f; NSA_FIN_ADD(rt, coef); }
        }
        __syncthreads();
        {   const LAS float* lh = lut + head * 128; const float bfar = lh[127];
            RowState rs[2]; rs_init(rs[0], M_INIT, 0.f); rs_init(rs[1], M_INIT, 0.f);
            const bf16* kb = kvb + 4 * KVB + bgS; const bf16* vb = kvb + 5 * KVB + bgS;
            const int jt0 = qb >= 8 ? qb - 8 : 0, ntile = qb - jt0 + 1;
            KVRegs kr; kv_fetch(kr, kb, vb, jt0 * 64, F.tid);
            for (int ti = 0; ti < ntile; ++ti) {
                const int buf = ti & 1; kv_put(kr, kt + buf * KT_BYTES, vt + buf * KT_BYTES, F.tid);
                __syncthreads();
                if (ti + 1 < ntile) kv_fetch(kr, kb, vb, (jt0 + ti + 1) * 64, F.tid);
                const int jt = jt0 + ti, kp0 = jt * 64;
                const bool mid = (jt + 3 <= qb) && (jt + 8 > qb);
#pragma unroll
                for (int ks = 0; ks < 2; ++ks) { bf16x8 kf[4], vf[4]; load_kfrag(kt + buf * KT_BYTES, 32 * ks, lane, kf); load_vfrag(vt + buf * KT_BYTES, 32 * ks, lane, vf);
#pragma unroll
                    for (int rt = 0; rt < 2; ++rt) { f32x4 v0, v1;
                        if (mid) softmax_fast(rs[rt], kf, qf[rt], bfar, v0, v1);
                        else { qk_mma(kf, qf[rt], v0, v1); bias_general2(v0, v1, tl[rt] - (kp0 + 32 * ks + 4 * kg), 512, true, lh); softmax_step(rs[rt], v0, v1); }
                        pv_mma(vf, v0, v1, rs[rt].o); } }
            }
#pragma unroll
            for (int rt = 0; rt < 2; ++rt) { const float lt = grp_sum(rs[rt].l); const float coef = lt > 0.f ? NSA_GATE(rt, 2) / lt : 0.f; NSA_FIN_ADD(rt, coef); }
        }
        if (mode == 0)
#pragma unroll
        for (int rt = 0; rt < 2; ++rt) {
            if (MIX_FP8) { unsigned char* op = F.ws + WS_ON + ((size_t)b * S + tl[rt]) * 1024 + head * 64 + 4 * kg;
#pragma unroll
                for (int dt = 0; dt < 4; ++dt) *(unsigned*)(op + 16 * dt) = pack_fp8x4(bflo(fin[rt][dt].x) * O8_SCALE, bfhi(fin[rt][dt].x) * O8_SCALE, bflo(fin[rt][dt].y) * O8_SCALE, bfhi(fin[rt][dt].y) * O8_SCALE); }
            else { bf16* op = wsb(F, WS_ON) + ((size_t)b * S + tl[rt]) * 512 + head * 64 + 4 * kg;
#pragma unroll
                for (int dt = 0; dt < 4; ++dt) *(v2u*)(op + 16 * dt) = fin[rt][dt]; } }
#undef NSA_GATE
#undef NSA_FIN_ADD
    }
    if (BG_CONV) { while (ccs < cnsteps || cpend) conv_tick(F, l, F.tid & 63, cgw, cNGW, cnsteps, ccs, cpend, ccv, cstg); }
}

constexpr int NPL = 10, NPH = 2 + NL * NPL;
struct Args { const float* in[21]; float* out; unsigned char* ws; int ph_lo, ph_hi; };
__global__ void __launch_bounds__(NTHR, 2) fwd(Args args) {
    extern __shared__ __attribute__((aligned(16))) unsigned char lds[];
    Frame F;
    F.lds = (LAS unsigned char*)lds; F.MISC = (volatile LAS unsigned*)(F.lds + MISC_OFF);
    F.tid = threadIdx.x; F.lane = F.tid & 63; F.wave = __builtin_amdgcn_readfirstlane(F.tid >> 6);
    F.G = gridDim.x; { const int bx = blockIdx.x; F.vcu = (F.G % 8 == 0) ? (bx % 8) * (F.G / 8) + bx / 8 : bx; }
    F.ws = args.ws; F.ctl = (unsigned*)(args.ws + WS_CTL); F.out = args.out;
    F.x = args.in[0]; F.c = args.in[1]; F.w_ada = args.in[2]; F.b_ada = args.in[3]; F.g_mix = args.in[4]; F.g_ffn = args.in[5]; F.g_final = args.in[6]; F.w_in = args.in[7];
    F.cmp_pos = args.in[8]; F.cmp_w1 = args.in[9]; F.cmp_w2 = args.in[10]; F.sinks = args.in[11]; F.rel_tab = args.in[12]; F.w_branch = args.in[13]; F.w_out = args.in[14];
    F.w_router = args.in[15]; F.b_router = args.in[16]; F.w_up = args.in[17]; F.b_up = args.in[18]; F.w_down = args.in[19]; F.b_down = args.in[20];
    for (int u = F.tid; u < (LDS_BYTES - MISC_OFF) / 4; u += NTHR) ((LAS unsigned*)(F.lds + MISC_OFF))[u] = 0u;
    __syncthreads();
    XcdBarrier bar; bar.bar = F.ctl + CW_BAR; bar.x = 0; bar.st = F.MISC;
#if !MK_PER_PHASE
    bar = xcd_barrier_post(F.ctl + CW_BAR, F.MISC);
#endif
    const int lo = args.ph_lo, hi = args.ph_hi;
#ifndef PH_EN
#define PH_EN 0xfff
#endif
#define EN(p) (((PH_EN) >> (p)) & 1)
#ifndef REP_MASK
#define REP_MASK 0x0
#endif
#ifndef NSA_PROBE_MODE
#define NSA_PROBE_MODE 0
#endif
#define REPS(p) (1 + (((REP_MASK) >> (p)) & 1))
#define IN(k) (lo <= (k) && (k) < hi)
#define SEAM(k) do { if (IN(k) && IN((k) + 1)) xcd_barrier(bar); } while (0)
#define PHASE_BEGIN() do { GAS unsigned char* _w = (GAS unsigned char*)args.ws; asm volatile("" : "+s"(_w)); F.ws = (unsigned char*)_w; F.ctl = (unsigned*)(F.ws + WS_CTL); int _t = threadIdx.x; asm volatile("" : "+v"(_t)); F.tid = _t; F.lane = _t & 63; F.wave = __builtin_amdgcn_readfirstlane(_t >> 6); } while (0)
    if (EN(0) && IN(0)) for (int rep = 0; rep < REPS(0); ++rep) { PHASE_BEGIN(); p0_prologue(F); }
    SEAM(0);
    if (EN(1) && IN(1)) for (int rep = 0; rep < REPS(1); ++rep) { PHASE_BEGIN(); p_norm0(F); }
    SEAM(1);
    for (int l = 0; l < NL; ++l) {
        const int pb = 2 + l * NPL;
        if (EN(2) && IN(pb + 0)) for (int rep = 0; rep < REPS(2); ++rep) { PHASE_BEGIN();
#if Z_FP8
            DenseSched<true> Sd{(const char*)(F.ws + WS_H8), (const char*)(F.ws + WS_WIN) + (size_t)l * NZ * 1024, NZ / 256, (T / 256) * (NZ / 256), F.G, F.vcu, 1024u, (size_t)256 * 1024, 1 << 30, 0};
            EpiZ E{F.ws}; pg8::gemm_phase<EpiZ, DenseSched<true>, true>(F.lds, 512, Sd, E, W8_E8M0, H8_E8M0); }
#else
            DenseSched<> Sd{(const char*)(F.ws + WS_H), (const char*)(F.ws + WS_WIN) + (size_t)l * NZ * 1024 * 2, NZ / 256, (T / 256) * (NZ / 256), F.G, F.vcu, 2048u, (size_t)256 * 1024 * 2, 1 << 30, 0};
            EpiZ E{F.ws}; pg8::gemm_phase(F.lds, 1024, Sd, E); }
#endif
        SEAM(pb + 0);
        if (EN(3) && IN(pb + 1)) for (int rep = 0; rep < REPS(3); ++rep) { PHASE_BEGIN();
            DenseSched<> Sd{(const char*)(F.ws + WS_KV), (const char*)(F.ws + WS_WC1) + (size_t)l * 2 * 512 * 1024 * 2, 2, 32 * 2, F.G, F.vcu, 2048u, (size_t)256 * 1024 * 2, 16, (size_t)512 * 1024 * 2};
            EpiF32 E{wsf(F, WS_UL), 512}; pg8::gemm_phase(F.lds, 1024, Sd, E);
            __syncthreads(); p_swa2(F, l); }
        SEAM(pb + 1);
        if (EN(4) && IN(pb + 2)) for (int rep = 0; rep < REPS(4); ++rep) { PHASE_BEGIN(); p_cmpfin(F, l); }
        SEAM(pb + 2);
        if (EN(5) && IN(pb + 3)) for (int rep = 0; rep < REPS(5); ++rep) { PHASE_BEGIN(); p_nsa2(F, l, rep ? NSA_PROBE_MODE : 0); }
        SEAM(pb + 3);
        if (EN(6) && IN(pb + 4)) for (int rep = 0; rep < REPS(6); ++rep) { PHASE_BEGIN();
#if MIX_FP8
            DenseSched<true> Sd{(const char*)(F.ws + WS_ON), (const char*)(F.ws + WS_WBR) + (size_t)l * 1024 * 1024, 4, (T / 256) * 4, F.G, F.vcu, 1024u, (size_t)256 * 1024, 1 << 30, 0};
            EpiMerge1 E{F.ws}; pg8::gemm_phase<EpiMerge1, DenseSched<true>, true>(F.lds, 512, Sd, E, MIX_E8M0, MIX_E8M0); }
#else
            MergeSched Sm{(const char*)(F.ws + WS_ON), (const char*)(F.ws + WS_WBR) + (size_t)l * 2 * 1024 * 512 * 2, F.G, F.vcu};
            EpiMerge E{F.ws}; pg8::gemm_phase(F.lds, 512, Sm, E); }
#endif
        SEAM(pb + 4);
        if (EN(7) && IN(pb + 5)) for (int rep = 0; rep < REPS(7); ++rep) { PHASE_BEGIN();
#if MIX_FP8
            DenseSched<true> Sd{(const char*)(F.ws + WS_MG), (const char*)(F.ws + WS_WOUT) + (size_t)l * 1024 * 1024, 4, (T / 256) * 4, F.G, F.vcu, 1024u, (size_t)256 * 1024, 1 << 30, 0};
#if RES_BF16
            EpiResidB E{l == 0 ? F.x : (const float*)nullptr, wsb(F, WS_XA), wsb(F, WS_XB), wsf(F, WS_MOD) + (size_t)l * NB * 6144 + 2 * 1024}; pg8::gemm_phase<EpiResidB, DenseSched<true>, true>(F.lds, 512, Sd, E, MIX_E8M0, MIX_E8M0); }
#else
            EpiResid E{l == 0 ? F.x : (const float*)wsf(F, WS_XA), wsf(F, WS_XB), wsf(F, WS_MOD) + (size_t)l * NB * 6144 + 2 * 1024}; pg8::gemm_phase<EpiResid, DenseSched<true>, true>(F.lds, 512, Sd, E, MIX_E8M0, MIX_E8M0); }
#endif
#else
            DenseSched<> Sd{(const char*)(F.ws + WS_MG), (const char*)(F.ws + WS_WOUT) + (size_t)l * 1024 * 1024 * 2, 4, (T / 256) * 4, F.G, F.vcu, 2048u, (size_t)256 * 1024 * 2, 1 << 30, 0};
            EpiResid E{l == 0 ? F.x : (const float*)wsf(F, WS_XA), wsf(F, WS_XB), wsf(F, WS_MOD) + (size_t)l * NB * 6144 + 2 * 1024}; pg8::gemm_phase(F.lds, 1024, Sd, E); }
#endif
        SEAM(pb + 5);
        if (EN(8) && IN(pb + 6)) for (int rep = 0; rep < REPS(8); ++rep) { PHASE_BEGIN(); p_router2(F, l); }
        SEAM(pb + 6);
        if (EN(9) && IN(pb + 7)) for (int rep = 0; rep < REPS(9); ++rep) { PHASE_BEGIN();
            build_tiles(F, l);
#if MOE_FP8_UP
            MoeSched<true> Sm{(const char*)(F.ws + WS_H8), (const char*)(F.ws + WS_WUP) + (size_t)l * NE * 2048 * 1024, wsi(F, WS_LIST), F.MISC, 8, F.G, F.vcu, (size_t)2048 * 1024, (size_t)256 * 1024, 1024u, true};
            EpiSwiglu<MOE_FP8_DN != 0> E{wsb(F, WS_HID), F.b_up + (size_t)l * NE * 2048, F.lds + MISC_OFF + MB_BIAS}; pg8::gemm_phase<EpiSwiglu<MOE_FP8_DN != 0>, MoeSched<true>, true>(F.lds, 512, Sm, E, W8_E8M0, H8_E8M0); }
#else
            MoeSched<true> Sm{(const char*)(F.ws + WS_H), (const char*)(F.ws + WS_WUP) + (size_t)l * NE * 2048 * 1024 * 2, wsi(F, WS_LIST), F.MISC, 8, F.G, F.vcu, (size_t)2048 * 1024 * 2, (size_t)256 * 1024 * 2, 2048u, true};
            EpiSwiglu<MOE_FP8_DN != 0> E{wsb(F, WS_HID), F.b_up + (size_t)l * NE * 2048, F.lds + MISC_OFF + MB_BIAS}; pg8::gemm_phase(F.lds, 1024, Sm, E); }
#endif
        SEAM(pb + 7);
        if (EN(10) && IN(pb + 8)) for (int rep = 0; rep < REPS(10); ++rep) { PHASE_BEGIN();
            build_tiles(F, l);
#if MOE_FP8_DN
            MoeSched<true> Sm{(const char*)(F.ws + WS_HID), (const char*)(F.ws + WS_WDN) + (size_t)l * NE * 1024 * 1024, wsi(F, WS_LIST), F.MISC, 4, F.G, F.vcu, (size_t)1024 * 1024, (size_t)256 * 1024, 1024u, false};
            EpiBias E{wsb(F, WS_EO), F.b_down + (size_t)l * NE * 1024, F.lds + MISC_OFF + MB_BIAS}; pg8::gemm_phase<EpiBias, MoeSched<true>, true>(F.lds, 512, Sm, E, W8_E8M0, HID8_E8M0); }
#else
            MoeSched<false> Sm{(const char*)(F.ws + WS_HID), (const char*)(F.ws + WS_WDN) + (size_t)l * NE * 1024 * 1024 * 2, wsi(F, WS_LIST), F.MISC, 4, F.G, F.vcu, (size_t)1024 * 1024 * 2, (size_t)256 * 1024 * 2, 2048u, false};
            EpiBias E{wsb(F, WS_EO), F.b_down + (size_t)l * NE * 1024, F.lds + MISC_OFF + MB_BIAS}; pg8::gemm_phase(F.lds, 1024, Sm, E); }
#endif
        SEAM(pb + 8);
        if (EN(11) && IN(pb + 9)) for (int rep = 0; rep < REPS(11); ++rep) { PHASE_BEGIN(); p_combine(F, l); }
        SEAM(pb + 9);
    }
#undef IN
#undef SEAM
}

extern "C" void kernel_launch(void* const* d_in, const int* in_sizes, int n_in, void* d_out, int out_size, void* d_ws, size_t ws_size, hipStream_t stream) {
    static int grid = 0;
    if (grid == 0) {
        if (n_in != 21 || out_size != T * D || ws_size < WS_END) { fprintf(stderr, "kernel_launch: unexpected problem (n_in %d, out %d, ws %zu < %zu)\n", n_in, out_size, ws_size, (size_t)WS_END); grid = -1; return; }
        int dev = 0, cus = 0, per_cu = 0;
        if (hipGetDevice(&dev) != hipSuccess || hipDeviceGetAttribute(&cus, hipDeviceAttributeMultiprocessorCount, dev) != hipSuccess) { grid = -1; return; }
        if (hipFuncSetAttribute((const void*)fwd, hipFuncAttributeMaxDynamicSharedMemorySize, LDS_BYTES) != hipSuccess) { fprintf(stderr, "kernel_launch: hipFuncSetAttribute failed\n"); grid = -1; return; }
        if (hipOccupancyMaxActiveBlocksPerMultiprocessor(&per_cu, (const void*)fwd, NTHR, LDS_BYTES) != hipSuccess || per_cu < 1) fprintf(stderr, "kernel_launch: occupancy query says %d\n", per_cu);
        (void)hipGetLastError();
        grid = cus;
    }
    if (grid < 0) return;
    if (hipMemsetAsync((char*)d_ws + WS_CTL, 0, CTL_BYTES, stream) != hipSuccess) return;
    Args a{};
    for (int i = 0; i < 21; ++i) a.in[i] = (const float*)d_in[i];
    a.out = (float*)d_out; a.ws = (unsigned char*)d_ws;
#if MK_PER_PHASE
    for (int ph = 0; ph < NPH; ++ph) { a.ph_lo = ph; a.ph_hi = ph + 1; hipLaunchKernelGGL(fwd, dim3(grid), dim3(NTHR), LDS_BYTES, stream, a); }
#else
    a.ph_lo = 0; a.ph_hi = NPH; hipLaunchKernelGGL(fwd, dim3(grid), dim3(NTHR), LDS_BYTES, stream, a);
#endif
}
```

```cpp
#include <hip/hip_runtime.h>
#include <cstdio>
#include <cstdint>

#ifndef MK_PER_PHASE
#define MK_PER_PHASE 0
#endif

#ifndef MOE_FP8_UP
#define MOE_FP8_UP 1
#endif
#ifndef MOE_FP8_DN
#define MOE_FP8_DN 1
#endif
#ifndef Z_FP8
#define Z_FP8 1
#endif
#ifndef MIX_FP8
#define MIX_FP8 1
#endif
#define GM_U8 1
#define EO_FP8 1
#define BG_CONV (MOE_FP8_UP && MOE_FP8_DN)
#ifndef RES_BF16
#define RES_BF16 1
#endif
#define GAS __attribute__((address_space(1)))
#define LAS __attribute__((address_space(3)))
typedef unsigned short bf16;
typedef unsigned v4u __attribute__((ext_vector_type(4)));
typedef unsigned v2u __attribute__((ext_vector_type(2)));
typedef float f32x4 __attribute__((ext_vector_type(4)));
typedef float f32x2 __attribute__((ext_vector_type(2)));
typedef short bf16x8 __attribute__((ext_vector_type(8)));
typedef __bf16 bf16v2 __attribute__((ext_vector_type(2)));
typedef int v4i __attribute__((ext_vector_type(4)));
typedef int v8i __attribute__((ext_vector_type(8)));

constexpr int NB = 4, S = 8192, T = NB * S, D = 1024, NL = 4, NE = 32, TOPK = 4;
constexpr int DIN = 4120, NZ = 4352;
constexpr int NCMP = 511, NCMPP = 512;
constexpr int APAD = T * TOPK + NE * 256;
constexpr float RMS_EPS = 1e-5f;

constexpr size_t MiB = 1u << 20;
constexpr size_t al(size_t x) { return (x + MiB - 1) & ~(MiB - 1); }
constexpr size_t WS_CTL = 0, CTL_BYTES = 1 * MiB;
constexpr size_t WS_MOD = WS_CTL + CTL_BYTES;
constexpr size_t WS_POSB = WS_MOD + al((size_t)NL * NB * 6144 * 4);
constexpr size_t WS_WIN = WS_POSB + MiB;
constexpr size_t WS_WBR = WS_WIN + al((size_t)NL * NZ * 1024 * 2);
constexpr size_t WS_WOUT = WS_WBR + al((size_t)NL * 2 * 1024 * 512 * 2);
constexpr size_t WS_WC1 = WS_WOUT + al((size_t)NL * 1024 * 1024 * 2);
constexpr size_t WS_WUP = WS_WC1 + al((size_t)NL * 2 * 512 * 1024 * 2);
constexpr size_t WS_WDN = WS_WUP + al((size_t)NL * NE * 2048 * 1024 * 2);
constexpr size_t WS_XA = WS_WDN + al((size_t)NL * NE * 1024 * 1024 * 2);
constexpr size_t WS_XB = WS_XA + al((size_t)T * D * 4);
constexpr size_t WS_H = WS_XB + al((size_t)T * D * 4);
constexpr size_t WS_QN = WS_H + al((size_t)T * D * 2);
constexpr size_t WS_QS = WS_QN + al((size_t)T * 512 * 2);
constexpr size_t KVB = (size_t)NB * 2 * S * 64;
constexpr size_t WS_KV = WS_QS + al((size_t)T * 512 * 2);
constexpr size_t WS_GM = WS_KV + al(8 * KVB * 2);
constexpr size_t WS_GN = WS_GM + al((size_t)T * 2048 * 2);
constexpr size_t WS_UL = WS_GN + al((size_t)T * 32 * 2);
constexpr size_t WS_CMP = WS_UL + al((size_t)8192 * 512 * 4);
constexpr size_t WS_ON = WS_CMP + al((size_t)2 * NB * 2 * 512 * 64 * 2);
constexpr size_t WS_OS = WS_ON + al((size_t)T * 512 * 2);
constexpr size_t WS_MG = WS_OS + al((size_t)T * 512 * 2);
constexpr size_t WS_MG2 = WS_MG + al((size_t)T * 1024 * 2);
constexpr size_t WS_TOPI = WS_MG2 + al((size_t)T * 1024 * 2);
constexpr size_t WS_GW = WS_TOPI + al((size_t)T * 4 * 4);
constexpr size_t WS_LIST = WS_GW + al((size_t)T * 4 * 4);
constexpr size_t WS_HID = WS_LIST + al((size_t)NE * T * 4);
constexpr size_t WS_EO = WS_HID + al((size_t)APAD * 1024 * 2);
constexpr size_t WS_H8 = WS_EO + al((size_t)APAD * 1024 * 2);
constexpr size_t WS_END = WS_H8 + al((size_t)T * D);
constexpr int CW_TMO = 0;
constexpr int CW_BAR = 4096;
constexpr int CW_CNT = 16384;

constexpr int RING_BYTES = 131072;
constexpr int MISC_OFF = RING_BYTES;
constexpr int LDS_BYTES = 147456;
constexpr int NWAVES = 8, NTHR = 512;

#define RLX_AGENT __ATOMIC_RELAXED, __HIP_MEMORY_SCOPE_AGENT
#define LDS_WAIT() asm volatile("s_waitcnt lgkmcnt(0)" ::: "memory")
#define VM_WAIT() asm volatile("s_waitcnt vmcnt(0)" ::: "memory")
__device__ __forceinline__ unsigned f2bf(float f) { unsigned u = __builtin_bit_cast(unsigned, f); return (u + 0x7fffu + ((u >> 16) & 1u)) >> 16; }
__device__ __forceinline__ unsigned pk2(float lo, float hi) { return f2bf(lo) | (f2bf(hi) << 16); }
__device__ __forceinline__ float bflo(unsigned w) { return __builtin_bit_cast(float, w << 16); }
__device__ __forceinline__ float bfhi(unsigned w) { return __builtin_bit_cast(float, w & 0xffff0000u); }
__device__ __forceinline__ unsigned cvt_pk_bf16(float lo, float hi) { unsigned r; asm volatile("v_cvt_pk_bf16_f32 %0, %1, %2" : "=v"(r) : "v"(lo), "v"(hi)); return r; }
__device__ __forceinline__ unsigned pack_fp8x4_raw(float a, float b, float c, float d) { unsigned w = __builtin_amdgcn_cvt_pk_fp8_f32(a, b, 0, false); return __builtin_amdgcn_cvt_pk_fp8_f32(c, d, w, true); }
__device__ __forceinline__ float sat8(float x) { return __builtin_amdgcn_fmed3f(x, -448.0f, 448.0f); }
__device__ __forceinline__ unsigned pack_fp8x4(float a, float b, float c, float d) { return pack_fp8x4_raw(sat8(a), sat8(b), sat8(c), sat8(d)); }
constexpr float W8_SCALE = 64.0f, H8_SCALE = 4.0f, HID8_SCALE = 4.0f, O8_SCALE = 16.0f, MG8_SCALE = 16.0f;
constexpr float EO8_SCALE = 16.0f;
constexpr int MIX_E8M0 = 0x7a7a7a7a;
constexpr int W8_E8M0 = 0x7b7b7b7b, H8_E8M0 = 0x7b7b7b7b, HID8_E8M0 = 0x7b7b7b7b;
__device__ __forceinline__ float sigmoidf_(float x) { return __builtin_amdgcn_rcpf(1.0f + __expf(-x)); }
__device__ __forceinline__ int dpp_x1i(int x) { return __builtin_amdgcn_update_dpp(0, x, 0xB1, 0xF, 0xF, true); }
__device__ __forceinline__ int dpp_x2i(int x) { return __builtin_amdgcn_update_dpp(0, x, 0x4E, 0xF, 0xF, true); }
__device__ __forceinline__ int dpp_hmi(int x) { return __builtin_amdgcn_update_dpp(0, x, 0x141, 0xF, 0xF, true); }
__device__ __forceinline__ float dpp_x1(float x) { return __builtin_bit_cast(float, dpp_x1i(__builtin_bit_cast(int, x))); }
__device__ __forceinline__ float dpp_x2(float x) { return __builtin_bit_cast(float, dpp_x2i(__builtin_bit_cast(int, x))); }
__device__ __forceinline__ float dpp_hm(float x) { return __builtin_bit_cast(float, dpp_hmi(__builtin_bit_cast(int, x))); }
__device__ __forceinline__ int dpp_rmi(int x) { return __builtin_amdgcn_update_dpp(0, x, 0x140, 0xF, 0xF, true); }
__device__ __forceinline__ float dpp_rm(float x) { return __builtin_bit_cast(float, dpp_rmi(__builtin_bit_cast(int, x))); }
__device__ __forceinline__ float quad_sum(float x) { x += dpp_x1(x); return x + dpp_x2(x); }
__device__ __forceinline__ float wave_sum(float v) {
    v += dpp_x1(v); v += dpp_x2(v); v += dpp_hm(v); v += dpp_rm(v);
    v += __shfl_xor(v, 16); v += __shfl_xor(v, 32);
    return v;
}

#define XB_TMO      128
#define XB_XCNT(j)  (256  + 64 * (j))
#define XB_XSUB(j)  (1280 + 64 * (j))
#define XB_XGEN(j)  (2304 + 64 * (j))
#define XB_TOP      3328
#define XB_TOPGEN   3392
#define XCD_BAR_WORDS 3456
#define XB_SPIN_CAP (1u << 22)
__device__ __forceinline__ unsigned xb_ld(unsigned* p)              { return __hip_atomic_load(p, __ATOMIC_RELAXED, __HIP_MEMORY_SCOPE_AGENT); }
__device__ __forceinline__ unsigned xb_add(unsigned* p, unsigned v) { return __hip_atomic_fetch_add(p, v, __ATOMIC_RELAXED, __HIP_MEMORY_SCOPE_AGENT); }
__device__ __forceinline__ unsigned xb_xcc_id() { return (unsigned)__builtin_amdgcn_s_getreg((3 << 11) | 20) & 0xFu; }
#define XB_SPIN(cond, bar) do { unsigned _sp = 0; while (cond) { __builtin_amdgcn_s_sleep(1); \
    if ((++_sp & 255u) == 0u) { if (xb_ld(&(bar)[XB_TMO])) break; if (_sp > XB_SPIN_CAP) { atomicAdd(&(bar)[XB_TMO], 1u); break; } } } } while (0)
struct XcdBarrier { unsigned* bar; unsigned x; volatile LAS unsigned* st; };
__device__ __forceinline__ XcdBarrier xcd_barrier_post(unsigned* bar, volatile LAS unsigned* st) {
    XcdBarrier b; b.bar = bar; b.x = xb_xcc_id(); b.st = st;
    if (threadIdx.x == 0) (void)xb_add(&bar[XB_XCNT(b.x)], 1u);
    return b;
}
__device__ __forceinline__ void xcd_barrier_complete(unsigned* bar, unsigned x, unsigned& nloc, unsigned& nx) {
    const unsigned G = gridDim.x * gridDim.y * gridDim.z;
    unsigned sum, cnt, mine, sp = 0u;
    for (;;) {
        sum = 0u; cnt = 0u; mine = 0u;
#pragma unroll
        for (unsigned j = 0; j < 16; ++j) { const unsigned c = xb_ld(&bar[XB_XCNT(j)]); sum += c; cnt += (c > 0u) ? 1u : 0u; mine = (j == x) ? c : mine; }
        if (sum == G) break;
        __builtin_amdgcn_s_sleep(1);
        if ((++sp & 255u) == 0u) { if (xb_ld(&bar[XB_TMO])) break; if (sp > XB_SPIN_CAP) { atomicAdd(&bar[XB_TMO], 1u); break; } }
    }
    nloc = mine > 0u ? mine : 1u; nx = cnt > 0u ? cnt : 1u;
}
__device__ __forceinline__ void xcd_barrier(const XcdBarrier& b) {
    asm volatile("s_waitcnt vmcnt(0)" ::: "memory");
    __syncthreads();
    if (threadIdx.x == 0) {
        unsigned* bar = b.bar;
        __builtin_amdgcn_s_waitcnt(0);
        unsigned nloc = b.st[0], nx = b.st[1];
        if (nloc == 0u) { xcd_barrier_complete(bar, b.x, nloc, nx); b.st[0] = nloc; b.st[1] = nx; }
        const unsigned old = xb_add(&bar[XB_XSUB(b.x)], 1u);
        const unsigned gen = old / nloc;
        if (old + 1u == (gen + 1u) * nloc) {
            __builtin_amdgcn_fence(__ATOMIC_RELEASE, "agent");
            asm volatile("s_waitcnt vmcnt(0)" ::: "memory");
            const unsigned og = xb_add(&bar[XB_TOP], 1u);
            const unsigned tg = og / nx;
            if (og + 1u == (tg + 1u) * nx) xb_add(&bar[XB_TOPGEN], 1u);
            else XB_SPIN(xb_ld(&bar[XB_TOPGEN]) == tg, bar);
            __builtin_amdgcn_fence(__ATOMIC_ACQUIRE, "agent");
            xb_add(&bar[XB_XGEN(b.x)], 1u);
            asm volatile("s_waitcnt vmcnt(0)" ::: "memory");
        } else {
            XB_SPIN(xb_ld(&bar[XB_XGEN(b.x)]) == gen, bar);
            __builtin_amdgcn_fence(__ATOMIC_ACQUIRE, "agent");
            asm volatile("s_waitcnt vmcnt(0)" ::: "memory");
        }
    }
    __syncthreads();
}

namespace pg8 {
constexpr int BM = 256, BK = 64, HALF = 128, HTB = HALF * BK * 2, STAGE_BYTES = 8 * HTB;
__host__ __device__ __forceinline__ int lds_byte(int r, int c) { const int st = (r >> 4) * 2 + (c >> 5), rr = r & 15, cc = c & 31, ob = rr * 64 + cc * 2; return st * 1024 + (ob ^ (((ob >> 9) & 1) << 5)); }
__host__ __device__ __forceinline__ void stage_rc(int b, int& R, int& C) { const int st = b / 1024, sb = b % 1024, swz = sb ^ (((sb >> 9) & 1) << 5); R = (st >> 1) * 16 + swz / 64; C = (st & 1) * 32 + (swz % 64) / 2; }
__host__ __device__ __forceinline__ int perm32(int rho) { const int n = rho >> 4, i = rho & 15; return 8 * (i >> 2) + 4 * n + (i & 3); }
struct Unit { int pm, pn, e, par; };
template <class Epi, class Sched, bool FP8 = false>
__device__ __forceinline__ void gemm_phase(LAS unsigned char* lds, const int K, const Sched& S, const Epi& E, const int sc_w = 0x7f7f7f7f, const int sc_a = 0x7f7f7f7f) {
    int tid = threadIdx.x; asm volatile("" : "+v"(tid));
    const int wid = __builtin_amdgcn_readfirstlane(tid >> 6), lane = tid & 63, wr = wid >> 2, wc = wid & 3, fr = lane & 15, fq = lane >> 4;
    const int nt = K / BK;
    unsigned voffA[2], voffB[2];
#pragma unroll
    for (int i = 0; i < 2; ++i) { int R, C; stage_rc(tid * 16 + i * 8192, R, C); const int Rb = Epi::PERM ? ((R & ~31) + perm32(R & 31)) : R; voffA[i] = (unsigned)(R * K + C) * 2u; voffB[i] = (unsigned)(Rb * K + C) * 2u; }
    const unsigned kstep = (unsigned)(BK * 2);
    const size_t hstep = (size_t)HALF * K * 2;
    const unsigned ldsw = (unsigned)wid * 1024u;
    const int aoff = lds_byte(wr * 64 + fr, fq * 8), boff = lds_byte(wc * 32 + fr, fq * 8);
#define PG8_SA(b, h) (((b) * 2 + (h)) * HTB)
#define PG8_SB(b, h) ((4 + (b) * 2 + (h)) * HTB)
#define PG8_STAGE_B(bufoff, gbase) do { _Pragma("unroll") for (int _i = 0; _i < 2; ++_i) \
        __builtin_amdgcn_global_load_lds((const unsigned*)((const char*)(gbase) + voffB[_i]), (LAS unsigned*)(lds + (bufoff) + ldsw + _i * 8192), 16, 0, 0); } while (0)
#define PG8_STAGE_A(bufoff, gbase, h, OFFS) do { _Pragma("unroll") for (int _i = 0; _i < 2; ++_i) { const char* _p; \
        if constexpr (Sched::GATHER) _p = (const char*)(gbase) + (OFFS)[h][_i]; else _p = (const char*)(gbase) + (size_t)(h) * hstep + voffA[_i]; \
        __builtin_amdgcn_global_load_lds((const unsigned*)_p, (LAS unsigned*)(lds + (bufoff) + ldsw + _i * 8192), 16, 0, 0); } } while (0)
#define PG8_LD8(p) __builtin_shufflevector(*(const LAS v4i*)(p), *(const LAS v4i*)((p) + 1024), 0, 1, 2, 3, 4, 5, 6, 7)
#define PG8_LDA(dst, b, h) do { _Pragma("unroll") for (int m = 0; m < 4; ++m) { if constexpr (FP8) dst##8[m] = PG8_LD8(lds + PG8_SA(b, h) + aoff + m * 2048); \
        else { _Pragma("unroll") for (int k = 0; k < 2; ++k) dst[m][k] = *(const LAS bf16x8*)(lds + PG8_SA(b, h) + aoff + m * 2048 + k * 1024); } } } while (0)
#define PG8_LDB(dst, b, h) do { _Pragma("unroll") for (int n = 0; n < 2; ++n) { if constexpr (FP8) dst##8[n] = PG8_LD8(lds + PG8_SB(b, h) + boff + n * 2048); \
        else { _Pragma("unroll") for (int k = 0; k < 2; ++k) dst[n][k] = *(const LAS bf16x8*)(lds + PG8_SB(b, h) + boff + n * 2048 + k * 1024); } } } while (0)
#define PG8_MMA(ai, bj, At, Bt) do { __builtin_amdgcn_s_setprio(1); _Pragma("unroll") for (int m = 0; m < 4; ++m) _Pragma("unroll") for (int n = 0; n < 2; ++n) { \
        if constexpr (FP8) acc[ai][bj][m][n] = __builtin_amdgcn_mfma_scale_f32_16x16x128_f8f6f4(Bt##8[n], At##8[m], acc[ai][bj][m][n], 0, 0, 0, sc_w, 0, sc_a); \
        else { _Pragma("unroll") for (int k = 0; k < 2; ++k) acc[ai][bj][m][n] = __builtin_amdgcn_mfma_f32_16x16x32_bf16(Bt[n][k], At[m][k], acc[ai][bj][m][n], 0, 0, 0); } } \
        __builtin_amdgcn_s_setprio(0); } while (0)
#define PG8_WAIT_V(n) asm volatile("s_waitcnt vmcnt(" #n ")" ::: "memory")
#define PG8_WAIT_L(n) asm volatile("s_waitcnt lgkmcnt(" #n ")" ::: "memory")
#define PG8_BAR __builtin_amdgcn_s_barrier()
#define PG8_SCHED __builtin_amdgcn_sched_barrier(0)
    Unit cur, nxt; int ui = 0;
    if (!S.next(0, cur)) return;
    f32x4 acc[2][2][4][2];
#pragma unroll
    for (int a = 0; a < 2; ++a)
#pragma unroll
        for (int b = 0; b < 2; ++b)
#pragma unroll
            for (int m = 0; m < 4; ++m)
#pragma unroll
                for (int n = 0; n < 2; ++n) acc[a][b][m][n] = (f32x4){0.f, 0.f, 0.f, 0.f};
    bf16x8 At[4][2], B0[2][2], B1[2][2]; v8i At8[4], B08[2], B18[2];
    unsigned coff[2][2] = {{0u, 0u}, {0u, 0u}};
    LAS v4u* const noff_slot = (LAS v4u*)(lds + STAGE_BYTES + 1024) + tid;
    if constexpr (Sched::GATHER) S.a_off(cur, coff);
    const char* cA = S.a_ptr(cur);
    const char* cB = S.b_base(cur);
    cur.par = 0;
    if constexpr (Epi::PRE) { if (wid == 0) E.pre(cur, lane); }
    PG8_STAGE_B(PG8_SB(0, 0), cB); PG8_STAGE_B(PG8_SB(0, 1), cB + hstep); PG8_STAGE_A(PG8_SA(0, 0), cA, 0, coff); PG8_STAGE_A(PG8_SA(0, 1), cA, 1, coff);
    if (wr == 1) PG8_BAR;
    PG8_WAIT_V(2); PG8_BAR;
    PG8_STAGE_B(PG8_SB(1, 0), cB + kstep); PG8_STAGE_A(PG8_SA(1, 0), cA + kstep, 0, coff); PG8_STAGE_B(PG8_SB(1, 1), cB + hstep + kstep);
    PG8_WAIT_V(6); PG8_BAR;
    unsigned ptok[2][2] = {{0u, 0u}, {0u, 0u}}; Unit nx2; bool has_n = false;
    if constexpr (Sched::GATHER) { has_n = S.next(1, nxt); if (has_n) S.a_tok(nxt, ptok); }
    for (;;) {
        bool has_next;
        if constexpr (Sched::GATHER) has_next = has_n; else has_next = S.next(ui + 1, nxt);
        const char* nA = cA; const char* nB = cB;
        if (has_next) { nA = S.a_ptr(nxt); nB = S.b_base(nxt); }
        if constexpr (Sched::GATHER) { unsigned tmp[2][2]; if (has_next) S.tok_off(ptok, tmp); else { tmp[0][0] = coff[0][0]; tmp[0][1] = coff[0][1]; tmp[1][0] = coff[1][0]; tmp[1][1] = coff[1][1]; }
            v4u w; w.x = tmp[0][0]; w.y = tmp[0][1]; w.z = tmp[1][0]; w.w = tmp[1][1]; *noff_slot = w;
            has_n = has_next && S.next(ui + 2, nx2); if (has_n) S.a_tok(nx2, ptok); }
#pragma unroll 1
        for (int t = 0; t < nt; t += 2) {
            if constexpr (Epi::MID) { if (t == nt / 2) { int tz = threadIdx.x; asm volatile("" : "+v"(tz)); const int wz = tz >> 6, lz = tz & 63; E.mid(acc, cur, wz >> 2, wz & 3, lz & 15, lz >> 4); } }
            const bool last = (t == nt - 2);
            const char* a1 = cA + (size_t)(t + 1) * kstep;
            const char* a2 = last ? nA : cA + (size_t)(t + 2) * kstep; const char* b2 = last ? nB : cB + (size_t)(t + 2) * kstep;
            const char* a3 = a2 + kstep; const char* b3 = b2 + kstep;
            PG8_LDB(B0, 0, 0); PG8_LDB(B1, 0, 1); PG8_SCHED; PG8_LDA(At, 0, 0); PG8_STAGE_A(PG8_SA(1, 1), a1, 1, coff);
            if constexpr (Sched::GATHER) { if (last) { const v4u w = *noff_slot; coff[0][0] = w.x; coff[0][1] = w.y; coff[1][0] = w.z; coff[1][1] = w.w; } }
            PG8_WAIT_V(8); PG8_WAIT_L(0); PG8_BAR; PG8_MMA(0, 0, At, B0); PG8_MMA(0, 1, At, B1); PG8_BAR; PG8_SCHED;
            PG8_LDA(At, 0, 1); PG8_STAGE_B(PG8_SB(0, 0), b2); PG8_STAGE_B(PG8_SB(0, 1), b2 + hstep); PG8_STAGE_A(PG8_SA(0, 0), a2, 0, coff);
            PG8_WAIT_V(8); PG8_WAIT_L(0); PG8_BAR; PG8_MMA(1, 0, At, B0); PG8_MMA(1, 1, At, B1); PG8_BAR; PG8_SCHED;
            PG8_LDB(B0, 1, 0); PG8_LDB(B1, 1, 1); PG8_SCHED; PG8_LDA(At, 1, 0); PG8_STAGE_A(PG8_SA(0, 1), a2, 1, coff);
            PG8_WAIT_V(8); PG8_WAIT_L(0); PG8_BAR; PG8_MMA(0, 0, At, B0); PG8_MMA(0, 1, At, B1); PG8_BAR; PG8_SCHED;
            PG8_LDA(At, 1, 1); PG8_STAGE_B(PG8_SB(1, 0), b3); PG8_STAGE_B(PG8_SB(1, 1), b3 + hstep); PG8_STAGE_A(PG8_SA(1, 0), a3, 0, coff);
            PG8_WAIT_V(8); PG8_WAIT_L(0); PG8_BAR; PG8_MMA(1, 0, At, B0); PG8_MMA(1, 1, At, B1); PG8_BAR; PG8_SCHED;
        }
        if (wr == 0) PG8_BAR;
        { int tz = threadIdx.x; asm volatile("" : "+v"(tz));
          const int wz = tz >> 6, lz = tz & 63; E(acc, cur, wz >> 2, wz & 3, lz & 15, lz >> 4); }
        if (!has_next) break;
#pragma unroll
        for (int a = 0; a < 2; ++a)
#pragma unroll
            for (int b = 0; b < 2; ++b)
#pragma unroll
                for (int m = 0; m < 4; ++m)
#pragma unroll
                    for (int n = 0; n < 2; ++n) acc[a][b][m][n] = (f32x4){0.f, 0.f, 0.f, 0.f};
        cur = nxt; cur.par = (ui + 1) & 1; cA = nA; cB = nB; ++ui; if constexpr (Sched::GATHER) nxt = nx2;
        if constexpr (Epi::PRE) { if (wid == 0) E.pre(cur, lane); }
        if (wr == 1) PG8_BAR;
    }
    PG8_WAIT_V(0);
    PG8_BAR;
#undef PG8_SA
#undef PG8_SB
#undef PG8_STAGE_A
#undef PG8_STAGE_B
#undef PG8_LDA
#undef PG8_LD8
#undef PG8_LDB
#undef PG8_MMA
#undef PG8_WAIT_V
#undef PG8_WAIT_L
#undef PG8_BAR
#undef PG8_SCHED
}
}
using pg8::Unit;

struct Frame {
    LAS unsigned char* lds;
    volatile LAS unsigned* MISC;
    unsigned* ctl;
    int tid, lane, wave, vcu, G;
    const float *x, *c, *w_ada, *b_ada, *g_mix, *g_ffn, *g_final, *w_in, *cmp_pos, *cmp_w1, *cmp_w2, *sinks, *rel_tab, *w_branch, *w_out, *w_router, *b_router, *w_up, *b_up, *w_down, *b_down;
    float* out; unsigned char* ws;
};
constexpr int MW_TSTART = 16;
constexpr int MW_CNT = 64;
constexpr int MB_BIAS = 13312;
constexpr int MB_TEXP = 12288;

template <bool GATHER_ = false>
struct DenseSched {
    static constexpr bool GATHER = GATHER_;
    const char* A; const char* B; int nN, nU, G, c; unsigned lda2; size_t btile; int bsplit_pm; size_t bsplit_stride;
    __device__ __forceinline__ bool next(int i, Unit& u) const { const int L = i * G + c; if (L >= nU) return false; u.pm = L / nN; u.pn = L - u.pm * nN; u.e = 0; return true; }
    __device__ __forceinline__ const char* a_ptr(const Unit& u) const { return GATHER ? A : A + (size_t)u.pm * 256 * lda2; }
    __device__ __forceinline__ void a_off(const Unit& u, unsigned (&off)[2][2]) const {
        int tz = threadIdx.x; asm volatile("" : "+v"(tz));
#pragma unroll
        for (int i = 0; i < 2; ++i) { int R, C; pg8::stage_rc(tz * 16 + i * 8192, R, C);
#pragma unroll
            for (int h = 0; h < 2; ++h) off[h][i] = (unsigned)(u.pm * 256 + h * 128 + R) * lda2 + (unsigned)C * 2u; } }
    __device__ __forceinline__ void a_tok(const Unit& u, unsigned (&tok)[2][2]) const { tok[0][0] = tok[0][1] = tok[1][0] = tok[1][1] = (unsigned)u.pm; }
    __device__ __forceinline__ void tok_off(const unsigned (&tok)[2][2], unsigned (&off)[2][2]) const { Unit u; u.pm = (int)tok[0][0]; u.pn = 0; u.e = 0; a_off(u, off); }
    __device__ __forceinline__ const char* b_base(const Unit& u) const { return B + (u.pm >= bsplit_pm ? bsplit_stride : (size_t)0) + (size_t)u.pn * btile; }
};
struct MergeSched {
    static constexpr bool GATHER = false;
    const char* A; const char* B; int G, c;
    __device__ __forceinline__ bool next(int i, Unit& u) const { const int L = (i >> 1) * G + c; if (L >= (T / 256) * 4) return false; u.pm = L >> 2; u.pn = L & 3; u.e = i & 1; return true; }
    __device__ __forceinline__ const char* a_ptr(const Unit& u) const { return A + (size_t)u.pm * 256 * 1024 + (u.e ? (size_t)(WS_OS - WS_ON) : (size_t)0); }
    __device__ __forceinline__ void a_off(const Unit&, unsigned (&)[2][2]) const {}
    __device__ __forceinline__ void a_tok(const Unit&, unsigned (&)[2][2]) const {}
    __device__ __forceinline__ void tok_off(const unsigned (&)[2][2], unsigned (&)[2][2]) const {}
    __device__ __forceinline__ const char* b_base(const Unit& u) const { return B + ((size_t)u.e * 1024 + (size_t)u.pn * 256) * 512 * 2; }
};
template <bool GATHER_>
struct MoeSched {
    static constexpr bool GATHER = GATHER_;
    const char* A; const char* B; const int* list; volatile LAS unsigned* M; int nN, G, c; size_t bexp  ; size_t btile; unsigned rowb  ; bool use_list  ;
    __device__ __forceinline__ bool next(int i, Unit& u) const {
        const int L = i * G + c; const int nU = (int)M[MW_TSTART + 32] * nN; if (L >= nU) return false;
        u.pm = L / nN; u.pn = L - u.pm * nN; u.e = (int)((volatile LAS unsigned char*)M)[MB_TEXP + u.pm]; return true; }
    __device__ __forceinline__ const char* a_ptr(const Unit& u) const { return GATHER ? A : A + (size_t)u.pm * 256 * rowb; }
    __device__ __forceinline__ void a_tok(const Unit& u, unsigned (&tok)[2][2]) const {
        int tz = threadIdx.x; asm volatile("" : "+v"(tz));
        const int p0 = (u.pm - (int)M[MW_TSTART + u.e]) * 256, cnt = (int)M[MW_CNT + u.e];
#pragma unroll
        for (int i = 0; i < 2; ++i) { int R, C; pg8::stage_rc(tz * 16 + i * 8192, R, C);
#pragma unroll
            for (int h = 0; h < 2; ++h) { const int p = p0 + h * 128 + R; tok[h][i] = (unsigned)(use_list ? (p < cnt ? list[(size_t)u.e * T + p] : 0) : (u.pm * 256 + h * 128 + R)); } }
    }
    __device__ __forceinline__ void tok_off(const unsigned (&tok)[2][2], unsigned (&off)[2][2]) const {
        int tz = threadIdx.x; asm volatile("" : "+v"(tz));
#pragma unroll
        for (int i = 0; i < 2; ++i) { int R, C; pg8::stage_rc(tz * 16 + i * 8192, R, C);
#pragma unroll
            for (int h = 0; h < 2; ++h) off[h][i] = tok[h][i] * rowb + (unsigned)C * 2u; }
    }
    __device__ __forceinline__ void a_off(const Unit& u, unsigned (&off)[2][2]) const { unsigned tok[2][2]; a_tok(u, tok); tok_off(tok, off); }
    __device__ __forceinline__ const char* b_base(const Unit& u) const { return B + (size_t)u.e * bexp + (size_t)u.pn * btile; }
};

__device__ __forceinline__ unsigned gate_u8x4(float a, float b, float c, float d) {
    const float qa = __builtin_amdgcn_fmed3f(sigmoidf_(a) * 255.0f, 1.0f, 255.0f), qb = __builtin_amdgcn_fmed3f(sigmoidf_(b) * 255.0f, 1.0f, 255.0f), qc = __builtin_amdgcn_fmed3f(sigmoidf_(c) * 255.0f, 1.0f, 255.0f), qd = __builtin_amdgcn_fmed3f(sigmoidf_(d) * 255.0f, 1.0f, 255.0f);
    unsigned w = 0u; w = __builtin_amdgcn_cvt_pk_u8_f32(qa, 0, w); w = __builtin_amdgcn_cvt_pk_u8_f32(qb, 1, w); w = __builtin_amdgcn_cvt_pk_u8_f32(qc, 2, w); w = __builtin_amdgcn_cvt_pk_u8_f32(qd, 3, w); return w; }
__device__ __forceinline__ float ub(unsigned w, int i) { return (float)((w >> (8 * i)) & 0xffu); }
struct EpiZ { static constexpr bool PRE = false, MID = false, PERM = true; unsigned char* ws;
    __device__ __forceinline__ void operator()(const f32x4 (&acc)[2][2][4][2], const Unit& u, int wr, int wc, int fr, int fq) const {
        const int pn = u.pn, tok0 = u.pm * 256, rowl0 = wr * 64 + fr, cw = wc * 32 + 8 * fq;
#pragma unroll
        for (int bj = 0; bj < 2; ++bj) {
            const int c256 = bj * 128 + cw; bf16* base; int ld; bool skip = false;
            if (pn < 2) { base = (bf16*)(ws + WS_QN) + (size_t)tok0 * 512 + pn * 256 + c256; ld = 512; }
            else if (pn < 5 || pn == 7) { const int kvi = (pn == 7 ? 6 : (pn - 2) * 2) + bj, g = cw >> 6, b = tok0 / S, s0 = tok0 % S;
                base = (bf16*)(ws + WS_KV) + ((size_t)(kvi * NB + b) * 2 + g) * S * 64 + (size_t)s0 * 64 + (cw & 63); ld = 64; }
            else if (pn < 7) { base = (bf16*)(ws + WS_QS) + (size_t)tok0 * 512 + (pn - 5) * 256 + c256; ld = 512; }
            else if (pn < 16) { base = (bf16*)(ws + WS_GM) + (size_t)tok0 * 2048 + (pn - 8) * 256 + c256; ld = 2048; }
            else { base = (bf16*)(ws + WS_GN) + (size_t)tok0 * 32 + c256; ld = 32; skip = c256 >= 32; }
            if (!skip) {
#pragma unroll
                for (int ai = 0; ai < 2; ++ai)
#pragma unroll
                    for (int m = 0; m < 4; ++m) { const f32x4 v0 = acc[ai][bj][m][0], v1 = acc[ai][bj][m][1];
                        if (GM_U8 && pn >= 8 && pn < 16) { unsigned char* g8 = ws + WS_GM + (size_t)(tok0 + rowl0 + ai * 128 + m * 16) * 2048 + (pn - 8) * 256 + c256;
                            v2u w; w.x = gate_u8x4(v0[0], v0[1], v0[2], v0[3]); w.y = gate_u8x4(v1[0], v1[1], v1[2], v1[3]); *(v2u*)g8 = w; }
                        else { v4u w; w.x = cvt_pk_bf16(v0[0], v0[1]); w.y = cvt_pk_bf16(v0[2], v0[3]); w.z = cvt_pk_bf16(v1[0], v1[1]); w.w = cvt_pk_bf16(v1[2], v1[3]);
                        *(v4u*)(base + (size_t)(rowl0 + ai * 128 + m * 16) * ld) = w; } }
            }
        }
    }
};
struct EpiF32 { static constexpr bool PRE = false, MID = false, PERM = false; float* C; int ldc;
    __device__ __forceinline__ void operator()(const f32x4 (&acc)[2][2][4][2], const Unit& u, int wr, int wc, int fr, int fq) const {
        const int row0 = u.pm * 256 + wr * 64 + fr, col0 = u.pn * 256 + wc * 32 + 4 * fq;
#pragma unroll
        for (int ai = 0; ai < 2; ++ai)
#pragma unroll
            for (int m = 0; m < 4; ++m) { float* rowp = C + (size_t)(row0 + ai * 128 + m * 16) * ldc + col0;
#pragma unroll
                for (int bj = 0; bj < 2; ++bj)
#pragma unroll
                    for (int n = 0; n < 2; ++n) *(f32x4*)(rowp + bj * 128 + n * 16) = acc[ai][bj][m][n]; }
    }
};
struct EpiMerge { static constexpr bool PRE = false, MID = false, PERM = true; unsigned char* ws;
    __device__ __forceinline__ void operator()(const f32x4 (&acc)[2][2][4][2], const Unit& u, int wr, int wc, int fr, int fq) const {
        const int row0 = u.pm * 256 + wr * 64 + fr, col0 = u.pn * 256 + wc * 32 + 8 * fq, pass = u.e;
        const bf16* GM = (const bf16*)(ws + WS_GM) + pass * 1024; bf16* MG2 = (bf16*)(ws + WS_MG2); bf16* MG = (bf16*)(ws + WS_MG);
#pragma unroll
        for (int ai = 0; ai < 2; ++ai)
#pragma unroll
            for (int m = 0; m < 4; ++m) { const size_t row = (size_t)(row0 + ai * 128 + m * 16);
#pragma unroll
                for (int bj = 0; bj < 2; ++bj) { const int col = col0 + bj * 128; const f32x4 v0 = acc[ai][bj][m][0], v1 = acc[ai][bj][m][1];
                    const v4u g = *(const v4u*)(GM + row * 2048 + col);
                    float r[8];
                    r[0] = v0[0] * sigmoidf_(bflo(g.x)); r[1] = v0[1] * sigmoidf_(bfhi(g.x)); r[2] = v0[2] * sigmoidf_(bflo(g.y)); r[3] = v0[3] * sigmoidf_(bfhi(g.y));
                    r[4] = v1[0] * sigmoidf_(bflo(g.z)); r[5] = v1[1] * sigmoidf_(bfhi(g.z)); r[6] = v1[2] * sigmoidf_(bflo(g.w)); r[7] = v1[3] * sigmoidf_(bfhi(g.w));
                    if (pass) { const v4u p = *(const v4u*)(MG2 + row * 1024 + col);
                        r[0] += bflo(p.x); r[1] += bfhi(p.x); r[2] += bflo(p.y); r[3] += bfhi(p.y); r[4] += bflo(p.z); r[5] += bfhi(p.z); r[6] += bflo(p.w); r[7] += bfhi(p.w); }
                    v4u w; w.x = cvt_pk_bf16(r[0], r[1]); w.y = cvt_pk_bf16(r[2], r[3]); w.z = cvt_pk_bf16(r[4], r[5]); w.w = cvt_pk_bf16(r[6], r[7]);
                    *(v4u*)((pass ? MG : MG2) + row * 1024 + col) = w; } }
    }
};
struct EpiMerge1 { static constexpr bool PRE = false, MID = true, PERM = true; unsigned char* ws;
    __device__ __forceinline__ void mid(f32x4 (&acc)[2][2][4][2], const Unit& u, int wr, int wc, int fr, int fq) const {
        const int row0 = u.pm * 256 + wr * 64 + fr, col0 = u.pn * 256 + wc * 32 + 8 * fq; const bf16* GM = (const bf16*)(ws + WS_GM);
#pragma unroll
        for (int ai = 0; ai < 2; ++ai)
#pragma unroll
            for (int m = 0; m < 4; ++m) { const size_t row = (size_t)(row0 + ai * 128 + m * 16);
#pragma unroll
                for (int bj = 0; bj < 2; ++bj) { const int col = col0 + bj * 128;
                    if (GM_U8) { const unsigned char* G8 = ws + WS_GM + row * 2048 + col; const v2u ga = *(const v2u*)G8, gb = *(const v2u*)(G8 + 1024);
#pragma unroll
                        for (int p = 0; p < 8; ++p) acc[ai][bj][m][p >> 2][p & 3] *= ub(p < 4 ? ga.x : ga.y, p & 3) * __builtin_amdgcn_rcpf(ub(p < 4 ? gb.x : gb.y, p & 3));
                        continue; }
                    const v4u ga = *(const v4u*)(GM + row * 2048 + col), gb = *(const v4u*)(GM + row * 2048 + 1024 + col);
                    const unsigned gaw[4] = {ga.x, ga.y, ga.z, ga.w}, gbw[4] = {gb.x, gb.y, gb.z, gb.w};
#pragma unroll
                    for (int p = 0; p < 4; ++p) {
                        const float r0 = (1.0f + __expf(-bflo(gbw[p]))) * __builtin_amdgcn_rcpf(1.0f + __expf(-bflo(gaw[p]))), r1 = (1.0f + __expf(-bfhi(gbw[p]))) * __builtin_amdgcn_rcpf(1.0f + __expf(-bfhi(gaw[p])));
                        acc[ai][bj][m][p >> 1][(p & 1) * 2] *= r0; acc[ai][bj][m][p >> 1][(p & 1) * 2 + 1] *= r1; } } }
    }
    __device__ __forceinline__ void operator()(const f32x4 (&acc)[2][2][4][2], const Unit& u, int wr, int wc, int fr, int fq) const {
        const int row0 = u.pm * 256 + wr * 64 + fr, col0 = u.pn * 256 + wc * 32 + 8 * fq; const bf16* GM = (const bf16*)(ws + WS_GM) + 1024; unsigned char* MG8 = ws + WS_MG;
#pragma unroll
        for (int ai = 0; ai < 2; ++ai)
#pragma unroll
            for (int m = 0; m < 4; ++m) { const size_t row = (size_t)(row0 + ai * 128 + m * 16);
#pragma unroll
                for (int bj = 0; bj < 2; ++bj) { const int col = col0 + bj * 128; const f32x4 v0 = acc[ai][bj][m][0], v1 = acc[ai][bj][m][1];
                    if (GM_U8) { const v2u g8 = *(const v2u*)(ws + WS_GM + row * 2048 + 1024 + col); constexpr float GS = MG8_SCALE / 255.0f;
                        v2u w; w.x = pack_fp8x4(v0[0] * ub(g8.x, 0) * GS, v0[1] * ub(g8.x, 1) * GS, v0[2] * ub(g8.x, 2) * GS, v0[3] * ub(g8.x, 3) * GS);
                        w.y = pack_fp8x4(v1[0] * ub(g8.y, 0) * GS, v1[1] * ub(g8.y, 1) * GS, v1[2] * ub(g8.y, 2) * GS, v1[3] * ub(g8.y, 3) * GS);
                        *(v2u*)(MG8 + row * 1024 + col) = w; continue; }
                    const v4u g = *(const v4u*)(GM + row * 2048 + col);
                    v2u w; w.x = pack_fp8x4(v0[0] * sigmoidf_(bflo(g.x)) * MG8_SCALE, v0[1] * sigmoidf_(bfhi(g.x)) * MG8_SCALE, v0[2] * sigmoidf_(bflo(g.y)) * MG8_SCALE, v0[3] * sigmoidf_(bfhi(g.y)) * MG8_SCALE);
                    w.y = pack_fp8x4(v1[0] * sigmoidf_(bflo(g.z)) * MG8_SCALE, v1[1] * sigmoidf_(bfhi(g.z)) * MG8_SCALE, v1[2] * sigmoidf_(bflo(g.w)) * MG8_SCALE, v1[3] * sigmoidf_(bfhi(g.w)) * MG8_SCALE);
                    *(v2u*)(MG8 + row * 1024 + col) = w; } }
    }
};
struct EpiResid { static constexpr bool PRE = false, MID = false, PERM = false; const float* xin; float* xout; const float* gate;
    __device__ __forceinline__ void operator()(const f32x4 (&acc)[2][2][4][2], const Unit& u, int wr, int wc, int fr, int fq) const {
        const int row0 = u.pm * 256 + wr * 64 + fr, col0 = u.pn * 256 + wc * 32 + 4 * fq; const int b = (u.pm * 256) / S;
        f32x4 gv[2][2];
#pragma unroll
        for (int bj = 0; bj < 2; ++bj)
#pragma unroll
            for (int n = 0; n < 2; ++n) gv[bj][n] = *(const f32x4*)(gate + (size_t)b * 6144 + col0 + bj * 128 + n * 16);
#pragma unroll
        for (int ai = 0; ai < 2; ++ai)
#pragma unroll
            for (int m = 0; m < 4; ++m) { const size_t off = (size_t)(row0 + ai * 128 + m * 16) * D + col0;
#pragma unroll
                for (int bj = 0; bj < 2; ++bj)
#pragma unroll
                    for (int n = 0; n < 2; ++n) { const f32x4 xi = *(const f32x4*)(xin + off + bj * 128 + n * 16); *(f32x4*)(xout + off + bj * 128 + n * 16) = xi + gv[bj][n] * acc[ai][bj][m][n]; } }
    }
};
struct EpiResidB { static constexpr bool PRE = false, MID = false, PERM = true; const float* xin32; const bf16* xin16; bf16* xout; const float* gate;
    __device__ __forceinline__ void operator()(const f32x4 (&acc)[2][2][4][2], const Unit& u, int wr, int wc, int fr, int fq) const {
        const int row0 = u.pm * 256 + wr * 64 + fr, col0 = u.pn * 256 + wc * 32 + 8 * fq; const int b = (u.pm * 256) / S;
        f32x4 gv[2][2];
#pragma unroll
        for (int bj = 0; bj < 2; ++bj)
#pragma unroll
            for (int n = 0; n < 2; ++n) gv[bj][n] = *(const f32x4*)(gate + (size_t)b * 6144 + col0 + bj * 128 + 4 * n);
#pragma unroll
        for (int ai = 0; ai < 2; ++ai)
#pragma unroll
            for (int m = 0; m < 4; ++m) { const size_t off = (size_t)(row0 + ai * 128 + m * 16) * D + col0;
#pragma unroll
                for (int bj = 0; bj < 2; ++bj) { f32x4 x0, x1;
                    if (xin32) { x0 = *(const f32x4*)(xin32 + off + bj * 128); x1 = *(const f32x4*)(xin32 + off + bj * 128 + 4); }
                    else { const v4u w = *(const v4u*)(xin16 + off + bj * 128); x0 = (f32x4){bflo(w.x), bfhi(w.x), bflo(w.y), bfhi(w.y)}; x1 = (f32x4){bflo(w.z), bfhi(w.z), bflo(w.w), bfhi(w.w)}; }
                    x0 = x0 + gv[bj][0] * acc[ai][bj][m][0]; x1 = x1 + gv[bj][1] * acc[ai][bj][m][1];
                    v4u o; o.x = cvt_pk_bf16(x0[0], x0[1]); o.y = cvt_pk_bf16(x0[2], x0[3]); o.z = cvt_pk_bf16(x1[0], x1[1]); o.w = cvt_pk_bf16(x1[2], x1[3]);
                    *(v4u*)(xout + off + bj * 128) = o; } }
    }
};
template <bool OUT8> struct EpiSwiglu { static constexpr bool PRE = true, MID = false, PERM = true; bf16* hid; const float* bias; LAS unsigned char* blds;
    __device__ __forceinline__ void pre(const Unit& u, int lane) const { __builtin_amdgcn_global_load_lds((const unsigned*)(bias + (size_t)u.e * 2048 + u.pn * 256 + 4 * lane), (LAS unsigned*)(blds + u.par * 1024), 16, 0, 0); }
    __device__ __forceinline__ void operator()(const f32x4 (&acc)[2][2][4][2], const Unit& u, int wr, int wc, int fr, int fq) const {
        const int row0 = u.pm * 256 + wr * 64 + fr, col0 = u.pn * 256 + wc * 32 + 8 * fq;
        f32x4 bv[2][2];
#pragma unroll
        for (int bj = 0; bj < 2; ++bj)
#pragma unroll
            for (int n = 0; n < 2; ++n) bv[bj][n] = *(const LAS f32x4*)(blds + u.par * 1024 + (wc * 32 + 8 * fq + bj * 128 + 4 * n) * 4);
#pragma unroll
        for (int ai = 0; ai < 2; ++ai)
#pragma unroll
            for (int m = 0; m < 4; ++m) { bf16* rowp = hid + (size_t)(row0 + ai * 128 + m * 16) * 1024 + (col0 >> 1);
#pragma unroll
                for (int bj = 0; bj < 2; ++bj) { const f32x4 v0 = acc[ai][bj][m][0] + bv[bj][0], v1 = acc[ai][bj][m][1] + bv[bj][1];
                    float hq[4];
#pragma unroll
                    for (int p = 0; p < 4; ++p) { float gl = p < 2 ? v0[2 * p] : v1[2 * p - 4], li = p < 2 ? v0[2 * p + 1] : v1[2 * p - 3];
                        gl = fminf(gl, 7.0f); li = fminf(fmaxf(li, -7.0f), 7.0f);
                        hq[p] = gl * __builtin_amdgcn_rcpf(1.0f + __builtin_amdgcn_exp2f(gl * (-1.702f * 1.4426950408889634f))) * (OUT8 ? li * HID8_SCALE + HID8_SCALE : li + 1.0f); }
                    if constexpr (OUT8) { unsigned char* r8 = (unsigned char*)hid + (size_t)(row0 + ai * 128 + m * 16) * 1024 + (col0 >> 1) + bj * 64;
                        *(unsigned*)r8 = pack_fp8x4_raw(hq[0], hq[1], hq[2], hq[3]); }
                    else { v2u w; w.x = cvt_pk_bf16(hq[0], hq[1]); w.y = cvt_pk_bf16(hq[2], hq[3]); *(v2u*)(rowp + bj * 64) = w; } } }
    }
};
struct EpiBias { static constexpr bool PRE = true, MID = false, PERM = true; bf16* eo; const float* bias; LAS unsigned char* blds;
    __device__ __forceinline__ void pre(const Unit& u, int lane) const { __builtin_amdgcn_global_load_lds((const unsigned*)(bias + (size_t)u.e * 1024 + u.pn * 256 + 4 * lane), (LAS unsigned*)(blds + u.par * 1024), 16, 0, 0); }
    __device__ __forceinline__ void operator()(const f32x4 (&acc)[2][2][4][2], const Unit& u, int wr, int wc, int fr, int fq) const {
        const int row0 = u.pm * 256 + wr * 64 + fr, col0 = u.pn * 256 + wc * 32 + 8 * fq;
        f32x4 bv[2][2];
#pragma unroll
        for (int bj = 0; bj < 2; ++bj)
#pragma unroll
            for (int n = 0; n < 2; ++n) bv[bj][n] = *(const LAS f32x4*)(blds + u.par * 1024 + (wc * 32 + 8 * fq + bj * 128 + 4 * n) * 4);
#pragma unroll
        for (int ai = 0; ai < 2; ++ai)
#pragma unroll
            for (int m = 0; m < 4; ++m) { bf16* rowp = eo + (size_t)(row0 + ai * 128 + m * 16) * 1024 + col0; unsigned char* rowp8 = (unsigned char*)eo + (size_t)(row0 + ai * 128 + m * 16) * 1024 + col0;
#pragma unroll
                for (int bj = 0; bj < 2; ++bj) { const f32x4 v0 = acc[ai][bj][m][0] + bv[bj][0], v1 = acc[ai][bj][m][1] + bv[bj][1];
                    if (EO_FP8) { const f32x4 x0 = v0 * EO8_SCALE, x1 = v1 * EO8_SCALE; v2u w; w.x = pack_fp8x4(x0[0], x0[1], x0[2], x0[3]); w.y = pack_fp8x4(x1[0], x1[1], x1[2], x1[3]); *(v2u*)(rowp8 + bj * 128) = w; }
                    else { v4u w; w.x = cvt_pk_bf16(v0[0], v0[1]); w.y = cvt_pk_bf16(v0[2], v0[3]); w.z = cvt_pk_bf16(v1[0], v1[1]); w.w = cvt_pk_bf16(v1[2], v1[3]);
                    *(v4u*)(rowp + bj * 128) = w; } } }
    }
};

__device__ __forceinline__ bf16* wsb(const Frame& F, size_t off) { return (bf16*)(F.ws + off); }
__device__ __forceinline__ float* wsf(const Frame& F, size_t off) { return (float*)(F.ws + off); }
__device__ __forceinline__ int* wsi(const Frame& F, size_t off) { return (int*)(F.ws + off); }

__device__ __forceinline__ void tr_item(const float* src, size_t ldn, int k0, int ns0, int nvalid, bf16* dst, size_t ldk, LAS float* scr, int lane) {
    const int n = lane & 31;
#pragma unroll 16
    for (int i = 0; i < 32; ++i) { const int kk = 2 * i + (lane >> 5); scr[kk * 33 + n] = (n < nvalid) ? src[(size_t)(k0 + kk) * ldn + ns0 + n] : 0.f; }
    LDS_WAIT(); asm volatile("" ::: "memory");
    const int c = lane & 7;
#pragma unroll
    for (int j = 0; j < 4; ++j) { const int nn = (lane >> 3) + 8 * j; const LAS float* s = scr + (8 * c) * 33 + nn;
        v4u o; o.x = pk2(s[0 * 33], s[1 * 33]); o.y = pk2(s[2 * 33], s[3 * 33]); o.z = pk2(s[4 * 33], s[5 * 33]); o.w = pk2(s[6 * 33], s[7 * 33]);
        *(v4u*)(dst + (size_t)nn * ldk + k0 + 8 * c) = o; }
    LDS_WAIT(); asm volatile("" ::: "memory");
}
__device__ __forceinline__ void tr_item8(const float* src, size_t ldn, int k0, int ns0, int nvalid, unsigned char* dst, size_t ldk, LAS float* scr, int lane, float sc) {
    const int n = lane & 31;
#pragma unroll 16
    for (int i = 0; i < 32; ++i) { const int kk = 2 * i + (lane >> 5); scr[kk * 33 + n] = (n < nvalid) ? src[(size_t)(k0 + kk) * ldn + ns0 + n] * sc : 0.f; }
    LDS_WAIT(); asm volatile("" ::: "memory");
    const int c = lane & 7;
#pragma unroll
    for (int j = 0; j < 4; ++j) { const int nn = (lane >> 3) + 8 * j; const LAS float* s = scr + (8 * c) * 33 + nn;
        v2u o; o.x = pack_fp8x4(s[0 * 33], s[1 * 33], s[2 * 33], s[3 * 33]); o.y = pack_fp8x4(s[4 * 33], s[5 * 33], s[6 * 33], s[7 * 33]);
        *(v2u*)(dst + (size_t)nn * ldk + k0 + 8 * c) = o; }
    LDS_WAIT(); asm volatile("" ::: "memory");
}
template <int R>
__device__ __forceinline__ void matvec_item(Frame& F, const float* W, size_t ldn, int K, int n0, const LAS float* a, LAS float* red, const float* bias, float* out, size_t ostride) {
    const int kper = K / NWAVES, kb = F.wave * kper; float acc[R];
#pragma unroll
    for (int r = 0; r < R; ++r) acc[r] = 0.f;
#pragma unroll 8
    for (int k = kb; k < kb + kper; ++k) { const float w = W[(size_t)k * ldn + n0 + F.lane];
#pragma unroll
        for (int r = 0; r < R; ++r) acc[r] += a[r * K + k] * w; }
#pragma unroll
    for (int r = 0; r < R; ++r) red[(F.wave * R + r) * 64 + F.lane] = acc[r];
    __syncthreads();
    if (F.tid < R * 64) { const int r = F.tid >> 6, ln = F.tid & 63; float s = bias ? bias[n0 + ln] : 0.f;
#pragma unroll
        for (int w = 0; w < NWAVES; ++w) s += red[(w * R + r) * 64 + ln];
        out[(size_t)r * ostride + n0 + ln] = s; }
    __syncthreads();
}
__device__ __forceinline__ void p0_prologue(Frame& F) {
    LAS float* avec = (LAS float*)F.lds; LAS float* red = (LAS float*)(F.lds + 16384);
    int loaded = -1;
    for (int it = blockIdx.x; it < NL * 96 + NL * 2 * 4; it += F.G) {
        if (it < NL * 96) { const int l = it / 96, cb = it % 96;
            if (loaded != 0) { __syncthreads(); for (int i = F.tid; i < NB * 1024; i += NTHR) { const float c = F.c[i]; avec[i] = c / (1.0f + __expf(-c)); } loaded = 0; __syncthreads(); }
            matvec_item<4>(F, F.w_ada + (size_t)l * 1024 * 6144, 6144, 1024, cb * 64, avec, red, F.b_ada + (size_t)l * 6144, wsf(F, WS_MOD) + (size_t)l * NB * 6144, 6144);
        } else { const int r = it - NL * 96, lk = r >> 2, cb = r & 3;
            __syncthreads(); for (int i = F.tid; i < 2048; i += NTHR) avec[i] = F.cmp_pos[(size_t)lk * 2048 + i]; loaded = 1 + lk; __syncthreads();
            matvec_item<1>(F, F.cmp_w1 + (size_t)lk * 2048 * 256, 256, 2048, cb * 64, avec, red, nullptr, wsf(F, WS_POSB) + (size_t)lk * 256, 0);
        }
    }
    __syncthreads();
    LAS float* scr = (LAS float*)(F.lds + F.wave * 16384);
    const int gw = F.vcu * NWAVES + F.wave, NGW = F.G * NWAVES;
    constexpr int I_WIN = NL * 136 * 16, I_WBR = NL * 2 * 32 * 8, I_WOUT = NL * 32 * 16, I_WC1 = NL * 2 * 2 * 8 * 16, I_WUP = BG_CONV ? 0 : NL * NE * 64 * 16, I_WDN = BG_CONV ? 0 : NL * NE * 32 * 16;
    constexpr int NITEMS = I_WIN + I_WBR + I_WOUT + I_WC1 + I_WUP + I_WDN;
    for (int it = gw; it < NITEMS; it += NGW) {
        int r = it;
        if (r < I_WIN) { const int l = r / (136 * 16), rr = r % (136 * 16), nb = rr / 16, kb = rr % 16, d0 = nb * 32;
            int ns0 = 0, nvalid = 0; if (d0 < 4096) { ns0 = d0 + (d0 >= 1280 ? 24 : 0); nvalid = 32; } else if (d0 == 4096) { ns0 = 1280; nvalid = 24; }
            if (Z_FP8) tr_item8(F.w_in + (size_t)l * 1024 * DIN, DIN, kb * 64, ns0, nvalid, F.ws + WS_WIN + ((size_t)l * NZ + d0) * 1024, 1024, scr, F.lane, W8_SCALE);
            else tr_item(F.w_in + (size_t)l * 1024 * DIN, DIN, kb * 64, ns0, nvalid, wsb(F, WS_WIN) + ((size_t)l * NZ + d0) * 1024, 1024, scr, F.lane);
            continue; } r -= I_WIN;
        if (r < I_WBR) { const int lb = r / 256, rr = r % 256, nb = rr / 8, kb = rr % 8;
            if (MIX_FP8) tr_item8(F.w_branch + (size_t)lb * 512 * 1024, 1024, kb * 64, nb * 32, 32, F.ws + WS_WBR + ((size_t)(lb >> 1) * 1024 + nb * 32) * 1024 + (lb & 1) * 512, 1024, scr, F.lane, W8_SCALE);
            else tr_item(F.w_branch + (size_t)lb * 512 * 1024, 1024, kb * 64, nb * 32, 32, wsb(F, WS_WBR) + ((size_t)lb * 1024 + nb * 32) * 512, 512, scr, F.lane);
            continue; } r -= I_WBR;
        if (r < I_WOUT) { const int l = r / 512, rr = r % 512, nb = rr / 16, kb = rr % 16;
            if (MIX_FP8) tr_item8(F.w_out + (size_t)l * 1024 * 1024, 1024, kb * 64, nb * 32, 32, F.ws + WS_WOUT + ((size_t)l * 1024 + nb * 32) * 1024, 1024, scr, F.lane, W8_SCALE);
            else tr_item(F.w_out + (size_t)l * 1024 * 1024, 1024, kb * 64, nb * 32, 32, wsb(F, WS_WOUT) + ((size_t)l * 1024 + nb * 32) * 1024, 1024, scr, F.lane);
            continue; } r -= I_WOUT;
        if (r < I_WC1) { const int lk = r / 256, half = (r / 128) & 1, rr = r % 128, nb = rr / 16, kb = rr % 16;
            tr_item(F.cmp_w1 + ((size_t)lk * 2048 + half * 1024) * 256, 256, kb * 64, nb * 32, 32, wsb(F, WS_WC1) + ((size_t)lk * 512 + half * 256 + nb * 32) * 1024, 1024, scr, F.lane); continue; } r -= I_WC1;
        if (r < I_WUP) { const int le = r / 1024, rr = r % 1024, nb = rr / 16, kb = rr % 16;
            if (MOE_FP8_UP) tr_item8(F.w_up + (size_t)le * 1024 * 2048, 2048, kb * 64, nb * 32, 32, F.ws + WS_WUP + ((size_t)le * 2048 + nb * 32) * 1024, 1024, scr, F.lane, W8_SCALE);
            else tr_item(F.w_up + (size_t)le * 1024 * 2048, 2048, kb * 64, nb * 32, 32, wsb(F, WS_WUP) + ((size_t)le * 2048 + nb * 32) * 1024, 1024, scr, F.lane);
            continue; } r -= I_WUP;
        { const int le = r / 512, rr = r % 512, nb = rr / 16, kb = rr % 16;
            if (MOE_FP8_DN) tr_item8(F.w_down + (size_t)le * 1024 * 1024, 1024, kb * 64, nb * 32, 32, F.ws + WS_WDN + ((size_t)le * 1024 + nb * 32) * 1024, 1024, scr, F.lane, W8_SCALE);
            else tr_item(F.w_down + (size_t)le * 1024 * 1024, 1024, kb * 64, nb * 32, 32, wsb(F, WS_WDN) + ((size_t)le * 1024 + nb * 32) * 1024, 1024, scr, F.lane); }
    }
}

__device__ __forceinline__ void load_row16(const float* row, int lane, f32x4 (&v)[4]) { const f32x4* p = (const f32x4*)row + lane;
#pragma unroll
    for (int j = 0; j < 4; ++j) v[j] = p[64 * j]; }
__device__ __forceinline__ void load_row16_bf(const bf16* row, int lane, f32x4 (&v)[4]) { const v2u* p = (const v2u*)row + lane;
#pragma unroll
    for (int j = 0; j < 4; ++j) { const v2u w = p[64 * j]; v[j] = (f32x4){bflo(w.x), bfhi(w.x), bflo(w.y), bfhi(w.y)}; } }
__device__ __forceinline__ float row_rstd(const f32x4 (&v)[4]) { float s = 0.f;
#pragma unroll
    for (int j = 0; j < 4; ++j) s += (v[j].x * v[j].x + v[j].y * v[j].y) + (v[j].z * v[j].z + v[j].w * v[j].w);
    return __builtin_amdgcn_rsqf(wave_sum(s) * (1.0f / D) + RMS_EPS); }
__device__ __forceinline__ void load_mod(const float* g, const float* sc, const float* sh, int lane, f32x4 (&A)[4], f32x4 (&Bv)[4]) {
#pragma unroll
    for (int j = 0; j < 4; ++j) { const f32x4 gg = ((const f32x4*)g)[64 * j + lane], s = ((const f32x4*)sc)[64 * j + lane]; A[j] = gg * (s + 1.0f); Bv[j] = ((const f32x4*)sh)[64 * j + lane]; } }
__device__ __forceinline__ void store_row_bf16(bf16* row, int lane, const f32x4 (&h)[4]) { v2u* o = (v2u*)row + lane;
#pragma unroll
    for (int j = 0; j < 4; ++j) { v2u w; w.x = cvt_pk_bf16(h[j].x, h[j].y); w.y = cvt_pk_bf16(h[j].z, h[j].w); o[64 * j] = w; } }

__device__ __forceinline__ void store_row_fp8(unsigned char* row, int lane, const f32x4 (&h)[4], float sc) { unsigned* o = (unsigned*)row + lane;
#pragma unroll
    for (int j = 0; j < 4; ++j) o[64 * j] = pack_fp8x4(h[j].x * sc, h[j].y * sc, h[j].z * sc, h[j].w * sc); }
__device__ __forceinline__ void p_norm0(Frame& F) {
    const int gw = F.vcu * NWAVES + F.wave, NGW = F.G * NWAVES, per = T / NGW;
    const float* mod = wsf(F, WS_MOD);
    for (int m0 = gw * 16; m0 < T; m0 += NGW * 16) {
        const int b = m0 / S; f32x4 A[4], Bv[4]; load_mod(F.g_mix, mod + (size_t)b * 6144 + 1024, mod + (size_t)b * 6144, F.lane, A, Bv);
        for (int i = 0; i < 16; ++i) { const int m = m0 + i; f32x4 v[4]; load_row16(F.x + (size_t)m * D, F.lane, v); const float rs = row_rstd(v);
#pragma unroll
            for (int j = 0; j < 4; ++j) v[j] = v[j] * rs * A[j] + Bv[j];
            if (Z_FP8) store_row_fp8(F.ws + WS_H8 + (size_t)m * D, F.lane, v, H8_SCALE); else store_row_bf16(wsb(F, WS_H) + (size_t)m * D, F.lane, v); }
    }
    (void)per;
}

__device__ __forceinline__ void build_tiles(Frame& F, int l) {
    __syncthreads();
    if (F.tid < 32) {
        const int e = F.tid; const int c = (int)__hip_atomic_load(F.ctl + CW_CNT + l * NE + e, RLX_AGENT); const int tiles = (c + 255) >> 8; int incl = tiles;
#pragma unroll
        for (int o = 1; o < 32; o <<= 1) { const int t = __shfl_up(incl, o, 32); incl += e >= o ? t : 0; }
        F.MISC[MW_CNT + e] = (unsigned)c; F.MISC[MW_TSTART + e] = (unsigned)(incl - tiles); if (e == 31) F.MISC[MW_TSTART + 32] = (unsigned)incl; }
    __syncthreads();
    { volatile LAS unsigned char* texp = (volatile LAS unsigned char*)F.MISC + MB_TEXP; const int nt = (int)F.MISC[MW_TSTART + 32];
      for (int rt = F.tid; rt < nt; rt += NTHR) { int e = 0;
          for (int j = 1; j < 32; ++j) e = ((int)F.MISC[MW_TSTART + j] <= rt) ? j : e;
          texp[rt] = (unsigned char)e; } }
    __syncthreads();
}

__device__ __forceinline__ void p_router(Frame& F, int l) {
    LAS float* hb = (LAS float*)(F.lds + F.wave * 4096);
    LAS int* lcnt = (LAS int*)(F.lds + 32768); LAS int* lbase = lcnt + 32; LAS int* sel = lcnt + 64;
    const float* mod = wsf(F, WS_MOD) + (size_t)l * NB * 6144; const float* xb = wsf(F, WS_XB);
    const float* Wr = F.w_router + (size_t)l * 1024 * 32;
    for (int chunk = blockIdx.x; chunk < T / 128; chunk += F.G) {
        if (F.tid < 32) lcnt[F.tid] = 0;
        __syncthreads();
        const int b = (chunk * 128) / S; f32x4 A[4], Bv[4]; load_mod(F.g_ffn + (size_t)l * D, mod + (size_t)b * 6144 + 4 * 1024, mod + (size_t)b * 6144 + 3 * 1024, F.lane, A, Bv);
        const int e = F.lane & 31, half = F.lane >> 5; const float br = F.b_router[l * 32 + e];
        for (int i = 0; i < 16; ++i) { const int tl = F.wave * 16 + i, t = chunk * 128 + tl;
            f32x4 v[4]; load_row16(xb + (size_t)t * D, F.lane, v); const float rs = row_rstd(v);
#pragma unroll
            for (int j = 0; j < 4; ++j) { v[j] = v[j] * rs * A[j] + Bv[j]; ((LAS f32x4*)hb)[64 * j + F.lane] = v[j]; }
            if (MOE_FP8_UP) { unsigned* h8 = (unsigned*)(F.ws + WS_H8 + (size_t)t * D) + F.lane;
#pragma unroll
                for (int j = 0; j < 4; ++j) h8[64 * j] = pack_fp8x4(v[j].x * H8_SCALE, v[j].y * H8_SCALE, v[j].z * H8_SCALE, v[j].w * H8_SCALE); }
            else store_row_bf16(wsb(F, WS_H) + (size_t)t * D, F.lane, v);
            LDS_WAIT(); asm volatile("" ::: "memory");
            float acc = 0.f; const float* wp = Wr + (size_t)(half * 512) * 32 + e; const LAS float* hp = hb + half * 512;
#pragma unroll 16
            for (int k = 0; k < 512; ++k) acc += hp[k] * wp[(size_t)k * 32];
            acc += __shfl_xor(acc, 32);
            float val = acc + br; int idx = e;
            float tv[4]; int ti[4];
#pragma unroll
            for (int r = 0; r < 4; ++r) { float bv = val; int bi = idx;
#pragma unroll
                for (int o = 16; o >= 1; o >>= 1) { const float ov = __shfl_xor(bv, o); const int oi = __shfl_xor(bi, o); if (ov > bv || (ov == bv && oi < bi)) { bv = ov; bi = oi; } }
                tv[r] = bv; ti[r] = bi; if (e == bi) val = -INFINITY; }
            const float e1 = __expf(tv[1] - tv[0]), e2 = __expf(tv[2] - tv[0]), e3 = __expf(tv[3] - tv[0]), inv = 1.0f / (1.0f + e1 + e2 + e3);
            if (F.lane == 0) { const float gk[4] = {inv, e1 * inv, e2 * inv, e3 * inv};
#pragma unroll
                for (int r = 0; r < 4; ++r) { const int rk = atomicAdd((int*)&lcnt[ti[r]], 1); sel[tl * 4 + r] = ti[r] | (rk << 8); wsf(F, WS_GW)[(size_t)t * 4 + r] = gk[r]; } }
            LDS_WAIT(); asm volatile("" ::: "memory");
        }
        __syncthreads();
        if (F.tid < 32) { const int c = lcnt[F.tid]; lbase[F.tid] = c ? (int)__hip_atomic_fetch_add(F.ctl + CW_CNT + l * NE + F.tid, (unsigned)c, RLX_AGENT) : 0; }
        __syncthreads();
        { const int w = sel[F.tid], ee = w & 255, pos = lbase[ee] + (w >> 8), t = chunk * 128 + (F.tid >> 2);
          wsi(F, WS_LIST)[(size_t)ee * T + pos] = t; wsi(F, WS_TOPI)[(size_t)t * 4 + (F.tid & 3)] = ee | (pos << 8); }
        __syncthreads();
    }
}

__device__ __forceinline__ void p_router2(Frame& F, int l) {
    LAS float* Wl = (LAS float*)F.lds;
    LAS float* AB = (LAS float*)(F.lds + MISC_OFF + 1024);
    LAS int* lcnt = (LAS int*)(F.lds + MISC_OFF + 1024 + 8192); LAS int* lbase = lcnt + 32; LAS int* sel = lcnt + 64; LAS float* rst = (LAS float*)(sel + 512);
    const float* mod = wsf(F, WS_MOD) + (size_t)l * NB * 6144; const float* xb = wsf(F, WS_XB);
    { const f32x4* Wr = (const f32x4*)(F.w_router + (size_t)l * 1024 * 32);
      for (int idx = F.tid; idx < 1024 * 8; idx += NTHR) { const int k = idx >> 3, c4 = idx & 7; *(LAS f32x4*)(Wl + k * 32 + ((4 * c4) ^ (((k >> 2) & 1) << 4))) = Wr[idx]; } }
    int curb = -1;
    for (int chunk = blockIdx.x; chunk < T / 128; chunk += F.G) {
        const int b = (chunk * 128) / S;
        __syncthreads();
        if (b != curb) { for (int i = F.tid; i < 1024; i += NTHR) { AB[i] = F.g_ffn[(size_t)l * D + i] * (1.0f + mod[(size_t)b * 6144 + 4 * 1024 + i]); AB[1024 + i] = mod[(size_t)b * 6144 + 3 * 1024 + i]; } curb = b; }
        if (F.tid < 32) lcnt[F.tid] = 0;
        __syncthreads();
        const int t0 = chunk * 128 + F.wave * 16;
#if RES_BF16
        v2u xq[2][4];
        { const v2u* p = (const v2u*)(wsb(F, WS_XB) + (size_t)t0 * D) + F.lane;
#pragma unroll
          for (int j = 0; j < 4; ++j) xq[0][j] = p[64 * j]; }
#endif
#pragma unroll
        for (int i = 0; i < 16; ++i) { const int t = t0 + i; f32x4 v[4];
#if RES_BF16
            if (i + 1 < 16) { const v2u* p = (const v2u*)(wsb(F, WS_XB) + (size_t)(t + 1) * D) + F.lane;
#pragma unroll
                for (int j = 0; j < 4; ++j) xq[(i + 1) & 1][j] = p[64 * j]; }
#pragma unroll
            for (int j = 0; j < 4; ++j) { const v2u w = xq[i & 1][j]; v[j] = (f32x4){bflo(w.x), bfhi(w.x), bflo(w.y), bfhi(w.y)}; }
#else
            load_row16(xb + (size_t)t * D, F.lane, v);
#endif
            const float rs = row_rstd(v);
#pragma unroll
            for (int j = 0; j < 4; ++j) v[j] = v[j] * rs * ((const LAS f32x4*)AB)[64 * j + F.lane] + ((const LAS f32x4*)(AB + 1024))[64 * j + F.lane];
            if (MOE_FP8_UP) store_row_fp8(F.ws + WS_H8 + (size_t)t * D, F.lane, v, H8_SCALE); else store_row_bf16(wsb(F, WS_H) + (size_t)t * D, F.lane, v);
            if (F.lane == 0) rst[F.wave * 16 + i] = rs; }
        LDS_WAIT(); asm volatile("" ::: "memory");
        const int r = F.lane & 15, kq = F.lane >> 4; const float rsr = rst[F.wave * 16 + r];
        const float* xrow = xb + (size_t)(t0 + r) * D + 4 * kq; const LAS float* wb = Wl + (4 * kq) * 32 + (r ^ ((kq & 1) << 4));
        const int e0 = r ^ ((kq & 1) << 4), d16 = (e0 ^ 16) - e0;
        f32x4 acc0 = {0.f, 0.f, 0.f, 0.f}, acc1 = {0.f, 0.f, 0.f, 0.f};
        const bf16* xrow16 = wsb(F, WS_XB) + (size_t)(t0 + r) * D + 4 * kq;
#pragma unroll 4
        for (int ip = 0; ip < 64; ++ip) { f32x4 x4; if (RES_BF16) { const v2u w = *(const v2u*)(xrow16 + 16 * ip); x4 = (f32x4){bflo(w.x), bfhi(w.x), bflo(w.y), bfhi(w.y)}; } else x4 = *(const f32x4*)(xrow + 16 * ip);
            const f32x4 h4 = x4 * rsr * *(const LAS f32x4*)(AB + 16 * ip + 4 * kq) + *(const LAS f32x4*)(AB + 1024 + 16 * ip + 4 * kq);
#pragma unroll
            for (int c = 0; c < 4; ++c) { const LAS float* wp = wb + (16 * ip + c) * 32; const float w0 = wp[0], w1 = wp[d16];
                acc0 = __builtin_amdgcn_mfma_f32_16x16x4f32(h4[c], w0, acc0, 0, 0, 0); acc1 = __builtin_amdgcn_mfma_f32_16x16x4f32(h4[c], w1, acc1, 0, 0, 0); } }
        const float br0 = F.b_router[l * 32 + r], br1 = F.b_router[l * 32 + 16 + r];
        float tv[4][4]; int ti[4][4];
#pragma unroll
        for (int jj = 0; jj < 4; ++jj) { float va = acc0[jj] + br0, vb = acc1[jj] + br1;
#pragma unroll
            for (int rr = 0; rr < 4; ++rr) { float bv = va >= vb ? va : vb; int bi = va >= vb ? r : r + 16;
#pragma unroll
                for (int o = 0; o < 4; ++o) { const float ov = o == 0 ? dpp_x1(bv) : o == 1 ? dpp_x2(bv) : o == 2 ? dpp_hm(bv) : dpp_rm(bv); const int oi = o == 0 ? dpp_x1i(bi) : o == 1 ? dpp_x2i(bi) : o == 2 ? dpp_hmi(bi) : dpp_rmi(bi); if (ov > bv || (ov == bv && oi < bi)) { bv = ov; bi = oi; } }
                tv[jj][rr] = bv; ti[jj][rr] = bi; if (bi == r) va = -INFINITY; if (bi == r + 16) vb = -INFINITY; } }
        if (r == 0) {
#pragma unroll
            for (int jj = 0; jj < 4; ++jj) { const int tl = F.wave * 16 + 4 * kq + jj; const int t = chunk * 128 + tl;
                const float e1 = __expf(tv[jj][1] - tv[jj][0]), e2 = __expf(tv[jj][2] - tv[jj][0]), e3 = __expf(tv[jj][3] - tv[jj][0]), inv = 1.0f / (1.0f + e1 + e2 + e3);
                const float gk[4] = {inv, e1 * inv, e2 * inv, e3 * inv};
#pragma unroll
                for (int rr = 0; rr < 4; ++rr) { const int rk = atomicAdd((int*)&lcnt[ti[jj][rr]], 1); sel[tl * 4 + rr] = ti[jj][rr] | (rk << 8); wsf(F, WS_GW)[(size_t)t * 4 + rr] = gk[rr]; } } }
        __syncthreads();
        if (F.tid < 32) { const int c = lcnt[F.tid]; lbase[F.tid] = c ? (int)__hip_atomic_fetch_add(F.ctl + CW_CNT + l * NE + F.tid, (unsigned)c, RLX_AGENT) : 0; }
        __syncthreads();
        { const int w = sel[F.tid], ee = w & 255, pos = lbase[ee] + (w >> 8), t = chunk * 128 + (F.tid >> 2);
          wsi(F, WS_LIST)[(size_t)ee * T + pos] = t; wsi(F, WS_TOPI)[(size_t)t * 4 + (F.tid & 3)] = ee | (pos << 8); }
    }
}

__device__ __forceinline__ void p_combine(Frame& F, int l) {
    build_tiles(F, l);
    const int gw = F.vcu * NWAVES + F.wave, NGW = F.G * NWAVES;
    const float* mod = wsf(F, WS_MOD) + (size_t)l * NB * 6144; const float* xb = wsf(F, WS_XB); const bf16* eo = wsb(F, WS_EO);
    for (int m0 = gw * 16; m0 < T; m0 += NGW * 16) {
        const int b = m0 / S; f32x4 A[4], Bv[4], ga[4];
#pragma unroll
        for (int j = 0; j < 4; ++j) ga[j] = ((const f32x4*)(mod + (size_t)b * 6144 + 5 * 1024))[64 * j + F.lane];
        if (l + 1 < NL) { const float* mod1 = wsf(F, WS_MOD) + (size_t)(l + 1) * NB * 6144 + (size_t)b * 6144; load_mod(F.g_mix + (size_t)(l + 1) * D, mod1 + 1024, mod1, F.lane, A, Bv); }
        else {
#pragma unroll
            for (int j = 0; j < 4; ++j) { A[j] = ((const f32x4*)F.g_final)[64 * j + F.lane]; Bv[j] = (f32x4){0.f, 0.f, 0.f, 0.f}; } }
#if RES_BF16
        const int4 wall = ((const int4*)wsi(F, WS_TOPI))[m0 + (F.lane & 15)]; const f32x4 gall = ((const f32x4*)wsf(F, WS_GW))[m0 + (F.lane & 15)];
        const float gax = gall.x, gay = gall.y, gaz = gall.z, gaw = gall.w; const int gbx = __builtin_bit_cast(int, gax), gby = __builtin_bit_cast(int, gay), gbz = __builtin_bit_cast(int, gaz), gbw = __builtin_bit_cast(int, gaw);
        v2u xbr[2][4], eor[2][4][4]; unsigned eo8r[2][4][4]; float gsb[2][4];
#define CMB_ISSUE(i, bf) do { const int t_ = m0 + (i); const v2u* xp_ = (const v2u*)(wsb(F, WS_XB) + (size_t)t_ * D) + F.lane; \
            _Pragma("unroll") for (int j = 0; j < 4; ++j) xbr[bf][j] = xp_[64 * j]; \
            const int wk_[4] = {__builtin_amdgcn_readlane(wall.x, (i)), __builtin_amdgcn_readlane(wall.y, (i)), __builtin_amdgcn_readlane(wall.z, (i)), __builtin_amdgcn_readlane(wall.w, (i))}; \
            gsb[bf][0] = __builtin_bit_cast(float, __builtin_amdgcn_readlane(gbx, (i))); gsb[bf][1] = __builtin_bit_cast(float, __builtin_amdgcn_readlane(gby, (i))); \
            gsb[bf][2] = __builtin_bit_cast(float, __builtin_amdgcn_readlane(gbz, (i))); gsb[bf][3] = __builtin_bit_cast(float, __builtin_amdgcn_readlane(gbw, (i))); \
            _Pragma("unroll") for (int k = 0; k < 4; ++k) { const int e_ = wk_[k] & 255, pos_ = wk_[k] >> 8; const size_t row_ = (size_t)F.MISC[MW_TSTART + e_] * 256 + pos_; \
                if (EO_FP8) { const unsigned* rq_ = (const unsigned*)((const unsigned char*)eo + row_ * 1024) + F.lane; _Pragma("unroll") for (int j = 0; j < 4; ++j) eo8r[bf][k][j] = rq_[64 * j]; } \
                else { const v2u* rp_ = (const v2u*)(eo + row_ * 1024) + F.lane; _Pragma("unroll") for (int j = 0; j < 4; ++j) eor[bf][k][j] = rp_[64 * j]; } } } while (0)
        CMB_ISSUE(0, 0);
#pragma unroll
        for (int i = 0; i < 16; ++i) { const int t = m0 + i; const int bf = i & 1;
            if (i + 1 < 16) { if (bf == 0) CMB_ISSUE(i + 1, 1); else CMB_ISSUE(i + 1, 0); }
            f32x4 v[4], acc[4];
#pragma unroll
            for (int j = 0; j < 4; ++j) { const v2u w = xbr[bf][j]; v[j] = (f32x4){bflo(w.x), bfhi(w.x), bflo(w.y), bfhi(w.y)}; acc[j] = (f32x4){0.f, 0.f, 0.f, 0.f}; }
#pragma unroll
            for (int k = 0; k < 4; ++k)
#pragma unroll
                for (int j = 0; j < 4; ++j) { if (EO_FP8) { const unsigned w = eo8r[bf][k][j]; const f32x2 lo = __builtin_amdgcn_cvt_pk_f32_fp8((int)w, false), hi = __builtin_amdgcn_cvt_pk_f32_fp8((int)w, true); acc[j] += (gsb[bf][k] * (1.0f / EO8_SCALE)) * (f32x4){lo[0], lo[1], hi[0], hi[1]}; }
                    else { const v2u w = eor[bf][k][j]; acc[j] += gsb[bf][k] * (f32x4){bflo(w.x), bfhi(w.x), bflo(w.y), bfhi(w.y)}; } }
#pragma unroll
            for (int j = 0; j < 4; ++j) v[j] = v[j] + ga[j] * acc[j];
            const float rs = row_rstd(v);
            if (l + 1 < NL) {
#pragma unroll
                for (int j = 0; j < 4; ++j) { v2u w; w.x = cvt_pk_bf16(v[j].x, v[j].y); w.y = cvt_pk_bf16(v[j].z, v[j].w); ((v2u*)(wsb(F, WS_XA) + (size_t)t * D))[64 * j + F.lane] = w; }
#pragma unroll
                for (int j = 0; j < 4; ++j) v[j] = v[j] * rs * A[j] + Bv[j];
                if (Z_FP8) store_row_fp8(F.ws + WS_H8 + (size_t)t * D, F.lane, v, H8_SCALE); else store_row_bf16(wsb(F, WS_H) + (size_t)t * D, F.lane, v);
            } else {
#pragma unroll
                for (int j = 0; j < 4; ++j) ((f32x4*)(F.out + (size_t)t * D))[64 * j + F.lane] = v[j] * rs * A[j];
            }
        }
#undef CMB_ISSUE
#else
        for (int i = 0; i < 16; ++i) { const int t = m0 + i;
            f32x4 v[4]; if (RES_BF16) load_row16_bf(wsb(F, WS_XB) + (size_t)t * D, F.lane, v); else load_row16(xb + (size_t)t * D, F.lane, v);
            f32x4 acc[4];
#pragma unroll
            for (int j = 0; j < 4; ++j) acc[j] = (f32x4){0.f, 0.f, 0.f, 0.f};
            const int4 w4 = *(const int4*)(wsi(F, WS_TOPI) + (size_t)t * 4); const f32x4 g4 = *(const f32x4*)(wsf(F, WS_GW) + (size_t)t * 4);
            const int ws_[4] = {w4.x, w4.y, w4.z, w4.w}; const float gs[4] = {g4.x, g4.y, g4.z, g4.w};
#pragma unroll
            for (int k = 0; k < 4; ++k) { const int e = ws_[k] & 255, pos = ws_[k] >> 8; const size_t row = (size_t)F.MISC[MW_TSTART + e] * 256 + pos;
                const v2u* rp = (const v2u*)(eo + row * 1024) + F.lane;
#pragma unroll
                for (int j = 0; j < 4; ++j) { const v2u w = rp[64 * j]; acc[j] += gs[k] * (f32x4){bflo(w.x), bfhi(w.x), bflo(w.y), bfhi(w.y)}; } }
#pragma unroll
            for (int j = 0; j < 4; ++j) v[j] = v[j] + ga[j] * acc[j];
            const float rs = row_rstd(v);
            if (l + 1 < NL) {
#pragma unroll
                for (int j = 0; j < 4; ++j) { if (RES_BF16) { v2u w; w.x = cvt_pk_bf16(v[j].x, v[j].y); w.y = cvt_pk_bf16(v[j].z, v[j].w); ((v2u*)(wsb(F, WS_XA) + (size_t)t * D))[64 * j + F.lane] = w; } else ((f32x4*)(wsf(F, WS_XA) + (size_t)t * D))[64 * j + F.lane] = v[j]; }
#pragma unroll
                for (int j = 0; j < 4; ++j) v[j] = v[j] * rs * A[j] + Bv[j];
                if (Z_FP8) store_row_fp8(F.ws + WS_H8 + (size_t)t * D, F.lane, v, H8_SCALE); else store_row_bf16(wsb(F, WS_H) + (size_t)t * D, F.lane, v);
            } else {
#pragma unroll
                for (int j = 0; j < 4; ++j) ((f32x4*)(F.out + (size_t)t * D))[64 * j + F.lane] = v[j] * rs * A[j];
            }
        }
#endif
    }
}

__device__ __forceinline__ float gelu_tanh(float x) { const float y = 0.7978845608028654f * (x + 0.044715f * x * x * x); const float t = 1.0f - 2.0f / (1.0f + __expf(2.0f * y)); return 0.5f * x * (1.0f + t); }
__device__ __forceinline__ void p_cmpfin(Frame& F, int l) {
    const int gw = F.vcu * NWAVES + F.wave, NGW = F.G * NWAVES;
    LAS float* w2l = (LAS float*)F.lds;
    LAS float* ab = (LAS float*)(F.lds + MISC_OFF + 1024 + F.wave * 1024);
    { const f32x4* src = (const f32x4*)(F.cmp_w2 + (size_t)l * 2 * 256 * 64); for (int i = F.tid; i < 2 * 256 * 64 / 4; i += NTHR) ((LAS f32x4*)w2l)[i] = src[i]; }
    __syncthreads();
    const float* ul = wsf(F, WS_UL);
    for (int it = gw; it < 2 * NB * 2 * NCMP; it += NGW) {
        const int kv = it / (NB * 2 * NCMP), r = it % (NB * 2 * NCMP), bg = r / NCMP, i = r % NCMP;
        const size_t ru = (size_t)kv * 4096 + bg * 512 + i; const float* posb = wsf(F, WS_POSB) + (size_t)(l * 2 + kv) * 256;
#pragma unroll
        for (int j = 0; j < 4; ++j) { const int n = F.lane + 64 * j; ab[n] = gelu_tanh(ul[ru * 512 + n] + ul[(ru + 1) * 512 + 256 + n] + posb[n]); }
        LDS_WAIT(); asm volatile("" ::: "memory");
        const LAS float* w2 = w2l + kv * 256 * 64 + F.lane; float o0 = 0.f, o1 = 0.f, o2 = 0.f, o3 = 0.f;
#pragma unroll 8
        for (int n = 0; n < 256; n += 4) { const f32x4 a = *(const LAS f32x4*)(ab + n); o0 += a[0] * w2[(n + 0) * 64]; o1 += a[1] * w2[(n + 1) * 64]; o2 += a[2] * w2[(n + 2) * 64]; o3 += a[3] * w2[(n + 3) * 64]; }
        wsb(F, WS_CMP)[((size_t)(kv * NB * 2 + bg) * 512 + i) * 64 + F.lane] = (bf16)f2bf((o0 + o1) + (o2 + o3));
        LDS_WAIT(); asm volatile("" ::: "memory");
    }
}

__device__ __forceinline__ int t5_bucket(int d) {
    if (d < 16) return d;
    return 16 + (d >= 19) + (d >= 21) + (d >= 24) + (d >= 27) + (d >= 31) + (d >= 35) + (d >= 40) + (d >= 46) + (d >= 52) + (d >= 59) + (d >= 67) + (d >= 77) + (d >= 87) + (d >= 99) + (d >= 113);
}
__device__ __forceinline__ void build_lut(Frame& F, LAS float* lut) {
    for (int i = F.tid; i < 16 * 128; i += NTHR) { const int h = i >> 7, d = i & 127; lut[i] = F.rel_tab[t5_bucket(d) * 16 + h]; }
    __syncthreads();
}
__device__ __forceinline__ float fdot2(unsigned a, unsigned b, float c) { return __builtin_amdgcn_fdot2_f32_bf16(__builtin_bit_cast(bf16v2, a), __builtin_bit_cast(bf16v2, b), c, false); }
__device__ __forceinline__ float dot64(const unsigned (&q)[32], const bf16* krow) {
    const v4u* kp = (const v4u*)krow; float s = 0.f;
#pragma unroll
    for (int i = 0; i < 8; ++i) { const v4u k = kp[i]; s = fdot2(q[4 * i], k.x, s); s = fdot2(q[4 * i + 1], k.y, s); s = fdot2(q[4 * i + 2], k.z, s); s = fdot2(q[4 * i + 3], k.w, s); }
    return s;
}
__device__ __forceinline__ void axpy64(float (&o)[64], float p, const bf16* vrow) {
    const v4u* vp = (const v4u*)vrow;
#pragma unroll
    for (int i = 0; i < 8; ++i) { const v4u v = vp[i];
        o[8 * i] += p * bflo(v.x); o[8 * i + 1] += p * bfhi(v.x); o[8 * i + 2] += p * bflo(v.y); o[8 * i + 3] += p * bfhi(v.y);
        o[8 * i + 4] += p * bflo(v.z); o[8 * i + 5] += p * bfhi(v.z); o[8 * i + 6] += p * bflo(v.w); o[8 * i + 7] += p * bfhi(v.w); }
}
__device__ __forceinline__ void attend_key(const unsigned (&q)[32], const bf16* krow, const bf16* vrow, float bias, float& m, float& l, float (&o)[64]) {
    const float s = dot64(q, krow) * 0.125f + bias;
    if (s > m) { const float a = __expf(m - s); l *= a;
#pragma unroll
        for (int d = 0; d < 64; ++d) o[d] *= a;
        m = s; }
    const float p = __expf(s - m); l += p; axpy64(o, p, vrow);
}
__device__ __forceinline__ void load_q(const bf16* qrow, unsigned (&q)[32]) { const v4u* p = (const v4u*)qrow;
#pragma unroll
    for (int i = 0; i < 8; ++i) { const v4u w = p[i]; q[4 * i] = w.x; q[4 * i + 1] = w.y; q[4 * i + 2] = w.z; q[4 * i + 3] = w.w; } }
__device__ __forceinline__ void store_o(bf16* orow, const float (&o)[64]) { v4u* p = (v4u*)orow;
#pragma unroll
    for (int i = 0; i < 8; ++i) { v4u w; w.x = cvt_pk_bf16(o[8 * i], o[8 * i + 1]); w.y = cvt_pk_bf16(o[8 * i + 2], o[8 * i + 3]); w.z = cvt_pk_bf16(o[8 * i + 4], o[8 * i + 5]); w.w = cvt_pk_bf16(o[8 * i + 6], o[8 * i + 7]); p[i] = w; } }

__device__ __forceinline__ void p_swa(Frame& F, int l) {
    LAS float* lut = (LAS float*)(F.lds + 98304);
    build_lut(F, lut);
    const bf16* KS = wsb(F, WS_KV) + 6 * KVB; const bf16* VS = wsb(F, WS_KV) + 7 * KVB;
    for (int it = blockIdx.x; it < NB * 2 * (S / 128); it += F.G) {
        const int b = it / (2 * (S / 128)), kvh = (it / (S / 128)) & 1, qb = it % (S / 128);
        const int qi = F.tid >> 2, hh = F.tid & 3, t = qb * 128 + qi, head = kvh * 4 + hh; const size_t tok = (size_t)b * S + t;
        unsigned q[32]; load_q(wsb(F, WS_QS) + tok * 512 + head * 64, q);
        float o[64];
#pragma unroll
        for (int d = 0; d < 64; ++d) o[d] = 0.f;
        float m = F.sinks[l * 8 + head], ls = 1.0f;
        const bf16* kb = KS + ((size_t)(b * 2 + kvh) * S) * 64; const bf16* vb = VS + ((size_t)(b * 2 + kvh) * S) * 64;
        const LAS float* lh = lut + (8 + head) * 128;
        for (int kk = 0; kk < 128; ++kk) { const int kpos = t - kk; if (kpos < 0) break; attend_key(q, kb + (size_t)kpos * 64, vb + (size_t)kpos * 64, lh[kk], m, ls, o); }
        const float inv = 1.0f / ls;
#pragma unroll
        for (int d = 0; d < 64; ++d) o[d] *= inv;
        store_o(wsb(F, WS_OS) + tok * 512 + head * 64, o);
    }
}

__device__ __forceinline__ void p_nsa(Frame& F, int l) {
    LAS float* lut = (LAS float*)(F.lds + 98304); LAS float* psl = (LAS float*)F.lds; LAS int* selidx = (LAS int*)(F.lds + 65536);
    build_lut(F, lut);
    const bf16* kvb = wsb(F, WS_KV);
    for (int it = blockIdx.x; it < NB * 2 * (S / 128); it += F.G) {
        const int b = it / (2 * (S / 128)), g = (it / (S / 128)) & 1, qb = it % (S / 128);
        const int qi = F.tid >> 2, hh = F.tid & 3, t = qb * 128 + qi, head = g * 4 + hh; const size_t tok = (size_t)b * S + t;
        __syncthreads();
        for (int i = F.tid; i < 128 * 128; i += NTHR) psl[i] = 0.f;
        __syncthreads();
        unsigned q[32]; load_q(wsb(F, WS_QN) + tok * 512 + head * 64, q);
        const bf16* gn = wsb(F, WS_GN) + tok * 32;
        float fin[64];
#pragma unroll
        for (int d = 0; d < 64; ++d) fin[d] = 0.f;
        const size_t bgS = (size_t)(b * 2 + g) * S * 64;
        {   const bf16* kc = wsb(F, WS_CMP) + (size_t)(b * 2 + g) * 512 * 64; const bf16* vc = kc + (size_t)NB * 2 * 512 * 64;
            const int nc = t >= 31 ? min((t - 31) / 16 + 1, NCMP) : 0;
            float m = -INFINITY, ls = 0.f;
            for (int i = 0; i < nc; ++i) { const float s = dot64(q, kc + (size_t)i * 64) * 0.125f; if (s > m) { ls *= __expf(m - s); m = s; } ls += __expf(s - m); }
            const float inv = nc > 0 ? 1.0f / ls : 0.f; const float gate = sigmoidf_(bflo((unsigned)gn[head]));
            for (int i = 0; i < nc; ++i) { const float s = dot64(q, kc + (size_t)i * 64) * 0.125f; const float p = __expf(s - m) * inv; axpy64(fin, p * gate, vc + (size_t)i * 64);
                float P = p + __shfl_xor(p, 1); P += __shfl_xor(P, 2);
                if (hh == 0) { const int j0 = i >> 2; LAS float* pr = psl + qi * 128;
                    if ((i & 3) == 0) { pr[j0] += P; if (j0 + 1 < 128) pr[j0 + 1] += P; } else if (j0 + 1 < 128) pr[j0 + 1] += 2.0f * P; } }
        }
        const int blk_t = t >> 6; const int nsel = blk_t < 16 ? blk_t + 1 : 16;
        LDS_WAIT(); asm volatile("" ::: "memory");
        if (hh == 0) { LAS int* si = selidx + qi * 16; LAS float* pr = psl + qi * 128;
            if (blk_t < 16) { for (int j = 0; j <= blk_t; ++j) si[j] = j; }
            else { si[0] = 0; si[1] = blk_t - 1; si[2] = blk_t;
                for (int r = 0; r < 13; ++r) { int best = 1; float bv = -1.0f;
                    for (int j = 1; j <= blk_t - 2; ++j) { const float v = pr[j]; if (v > bv) { bv = v; best = j; } }
                    si[3 + r] = best; pr[best] = -2.0f; } } }
        LDS_WAIT(); asm volatile("" ::: "memory");
        {   const bf16* kb = kvb + 2 * KVB + bgS; const bf16* vb = kvb + 3 * KVB + bgS; const LAS float* lh = lut + head * 128;
            float m = -INFINITY, ls = 0.f;
            for (int jj = 0; jj < nsel; ++jj) { const int j = selidx[qi * 16 + jj];
                for (int kk = 0; kk < 64; ++kk) { const int kpos = j * 64 + kk; if (kpos > t) break; const int dist = t - kpos;
                    const float s = dot64(q, kb + (size_t)kpos * 64) * 0.125f + lh[dist < 127 ? dist : 127]; if (s > m) { ls *= __expf(m - s); m = s; } ls += __expf(s - m); } }
            const float coef = sigmoidf_(bflo((unsigned)gn[8 + head])) / ls;
            for (int jj = 0; jj < nsel; ++jj) { const int j = selidx[qi * 16 + jj];
                for (int kk = 0; kk < 64; ++kk) { const int kpos = j * 64 + kk; if (kpos > t) break; const int dist = t - kpos;
                    const float s = dot64(q, kb + (size_t)kpos * 64) * 0.125f + lh[dist < 127 ? dist : 127]; axpy64(fin, __expf(s - m) * coef, vb + (size_t)kpos * 64); } }
        }
        {   const bf16* kb = kvb + 4 * KVB + bgS; const bf16* vb = kvb + 5 * KVB + bgS; const LAS float* lh = lut + head * 128;
            float m = -INFINITY, ls = 0.f;
            for (int kk = 0; kk < 512; ++kk) { const int kpos = t - kk; if (kpos < 0) break;
                const float s = dot64(q, kb + (size_t)kpos * 64) * 0.125f + lh[kk < 127 ? kk : 127]; if (s > m) { ls *= __expf(m - s); m = s; } ls += __expf(s - m); }
            const float coef = sigmoidf_(bflo((unsigned)gn[16 + head])) / ls;
            for (int kk = 0; kk < 512; ++kk) { const int kpos = t - kk; if (kpos < 0) break;
                const float s = dot64(q, kb + (size_t)kpos * 64) * 0.125f + lh[kk < 127 ? kk : 127]; axpy64(fin, __expf(s - m) * coef, vb + (size_t)kpos * 64); }
        }
        store_o(wsb(F, WS_ON) + tok * 512 + head * 64, fin);
    }
}

typedef short v4i16_t __attribute__((ext_vector_type(4)));
constexpr int KT_STRIDE = 144;
constexpr int KT_BYTES = 64 * KT_STRIDE;
__device__ __forceinline__ v4i16_t vtr(const LAS unsigned char* p) { return __builtin_amdgcn_ds_read_tr16_b64_v4i16((LAS v4i16_t*)p); }
__device__ __forceinline__ f32x4 mfma16(bf16x8 a, bf16x8 b, f32x4 c) { return __builtin_amdgcn_mfma_f32_16x16x32_bf16(a, b, c, 0, 0, 0); }
struct KVRegs { v4u k, v; };
__device__ __forceinline__ void kv_fetch(KVRegs& r, const bf16* kg, const bf16* vg, int row0, int tid) { const size_t o = (size_t)(row0 + (tid >> 3)) * 64 + (tid & 7) * 8; r.k = *(const v4u*)(kg + o); r.v = *(const v4u*)(vg + o); }
__device__ __forceinline__ void kv_put(const KVRegs& r, LAS unsigned char* kt, LAS unsigned char* vt, int tid) { const int o = (tid >> 3) * KT_STRIDE + (tid & 7) * 16; *(LAS v4u*)(kt + o) = r.k; *(LAS v4u*)(vt + o) = r.v; }
__device__ __forceinline__ void load_qfrag(const bf16* qrow, int kg, bf16x8 (&qf)[2]) {
#pragma unroll
    for (int hf = 0; hf < 2; ++hf) { const v4u w = *(const v4u*)(qrow + 32 * hf + 8 * kg); v4u o;
        constexpr float QS = 0.125f * 1.4426950408889634f;
        o.x = cvt_pk_bf16(bflo(w.x) * QS, bfhi(w.x) * QS); o.y = cvt_pk_bf16(bflo(w.y) * QS, bfhi(w.y) * QS);
        o.z = cvt_pk_bf16(bflo(w.z) * QS, bfhi(w.z) * QS); o.w = cvt_pk_bf16(bflo(w.w) * QS, bfhi(w.w) * QS);
        qf[hf] = __builtin_bit_cast(bf16x8, o); } }
__device__ __forceinline__ void qk_step(const LAS unsigned char* kt, int r0, int lane, const bf16x8 (&qf)[2], f32x4& s0, f32x4& s1) {
    const LAS unsigned char* kp = kt + (r0 + (lane & 15)) * KT_STRIDE + (lane >> 4) * 16;
    const bf16x8 k00 = *(const LAS bf16x8*)kp, k01 = *(const LAS bf16x8*)(kp + 64), k10 = *(const LAS bf16x8*)(kp + 16 * KT_STRIDE), k11 = *(const LAS bf16x8*)(kp + 16 * KT_STRIDE + 64);
    const f32x4 z = {0.f, 0.f, 0.f, 0.f};
    s0 = mfma16(k00, qf[0], z); s0 = mfma16(k01, qf[1], s0);
    s1 = mfma16(k10, qf[0], z); s1 = mfma16(k11, qf[1], s1);
}
__device__ __forceinline__ void pv_step(const LAS unsigned char* vt, int r0, int lane, const f32x4& p0, const f32x4& p1, f32x4 (&o)[4]) {
    v4u pw; pw.x = cvt_pk_bf16(p0[0], p0[1]); pw.y = cvt_pk_bf16(p0[2], p0[3]); pw.z = cvt_pk_bf16(p1[0], p1[1]); pw.w = cvt_pk_bf16(p1[2], p1[3]);
    const bf16x8 pf = __builtin_bit_cast(bf16x8, pw);
    const LAS unsigned char* vp = vt + (r0 + 4 * (lane >> 4) + ((lane & 15) >> 2)) * KT_STRIDE + (lane & 3) * 8;
#pragma unroll
    for (int dt = 0; dt < 4; ++dt) { const v4i16_t a = vtr(vp + dt * 32), b = vtr(vp + 16 * KT_STRIDE + dt * 32);
        bf16x8 vf; vf[0] = a[0]; vf[1] = a[1]; vf[2] = a[2]; vf[3] = a[3]; vf[4] = b[0]; vf[5] = b[1]; vf[6] = b[2]; vf[7] = b[3];
        o[dt] = mfma16(vf, pf, o[dt]); }
}
__device__ __forceinline__ void load_kfrag(const LAS unsigned char* kt, int r0, int lane, bf16x8 (&kf)[4]) {
    const LAS unsigned char* kp = kt + (r0 + (lane & 15)) * KT_STRIDE + (lane >> 4) * 16;
    kf[0] = *(const LAS bf16x8*)kp; kf[1] = *(const LAS bf16x8*)(kp + 64); kf[2] = *(const LAS bf16x8*)(kp + 16 * KT_STRIDE); kf[3] = *(const LAS bf16x8*)(kp + 16 * KT_STRIDE + 64);
}
__device__ __forceinline__ void qk_mma(const bf16x8 (&kf)[4], const bf16x8 (&qf)[2], f32x4& s0, f32x4& s1, float c0 = 0.f) {
    const f32x4 z = {c0, c0, c0, c0};
    __builtin_amdgcn_s_setprio(1);
    s0 = mfma16(kf[0], qf[0], z); s1 = mfma16(kf[2], qf[0], z); s0 = mfma16(kf[1], qf[1], s0); s1 = mfma16(kf[3], qf[1], s1);
    __builtin_amdgcn_s_setprio(0);
}
__device__ __forceinline__ void load_vfrag(const LAS unsigned char* vt, int r0, int lane, bf16x8 (&vf)[4]) {
    const LAS unsigned char* vp = vt + (r0 + 4 * (lane >> 4) + ((lane & 15) >> 2)) * KT_STRIDE + (lane & 3) * 8;
#pragma unroll
    for (int dt = 0; dt < 4; ++dt) { const v4i16_t a = vtr(vp + dt * 32), b = vtr(vp + 16 * KT_STRIDE + dt * 32);
        vf[dt][0] = a[0]; vf[dt][1] = a[1]; vf[dt][2] = a[2]; vf[dt][3] = a[3]; vf[dt][4] = b[0]; vf[dt][5] = b[1]; vf[dt][6] = b[2]; vf[dt][7] = b[3]; }
}
__device__ __forceinline__ void pv_mma(const bf16x8 (&vf)[4], const f32x4& p0, const f32x4& p1, f32x4 (&o)[4]) {
    v4u pw; pw.x = cvt_pk_bf16(p0[0], p0[1]); pw.y = cvt_pk_bf16(p0[2], p0[3]); pw.z = cvt_pk_bf16(p1[0], p1[1]); pw.w = cvt_pk_bf16(p1[2], p1[3]);
    const bf16x8 pf = __builtin_bit_cast(bf16x8, pw);
    __builtin_amdgcn_s_setprio(1);
#pragma unroll
    for (int dt = 0; dt < 4; ++dt) o[dt] = mfma16(vf[dt], pf, o[dt]);
    __builtin_amdgcn_s_setprio(0);
}
constexpr float LOG2E = 1.4426950408889634f;
constexpr float M_INIT = -1.0e30f;
struct RowState { float m, l; f32x4 o[4]; };
__device__ __forceinline__ void rs_init(RowState& r, float m0, float l0) { r.m = m0; r.l = l0;
#pragma unroll
    for (int dt = 0; dt < 4; ++dt) r.o[dt] = (f32x4){0.f, 0.f, 0.f, 0.f}; }
__device__ __forceinline__ float grp_max(float x) { x = fmaxf(x, __shfl_xor(x, 16)); return fmaxf(x, __shfl_xor(x, 32)); }
__device__ __forceinline__ float grp_sum(float x) { x += __shfl_xor(x, 16); return x + __shfl_xor(x, 32); }
__device__ __forceinline__ float max8(const f32x4& v0, const f32x4& v1) { return fmaxf(fmaxf(fmaxf(v0[0], v0[1]), fmaxf(v0[2], v0[3])), fmaxf(fmaxf(v1[0], v1[1]), fmaxf(v1[2], v1[3]))); }
__device__ __forceinline__ int fbits(float x) { return __builtin_bit_cast(int, x); }
__device__ __forceinline__ int imax8(const f32x4& a, const f32x4& b) {
    const float a0 = a[0], a1 = a[1], a2 = a[2], a3 = a[3], b0 = b[0], b1 = b[1], b2 = b[2], b3 = b[3];
    const int i0 = max(max(fbits(a0), fbits(a1)), fbits(a2)), i1 = max(max(fbits(a3), fbits(b0)), fbits(b1));
    return max(max(i0, i1), max(fbits(b2), fbits(b3)));
}
__device__ __forceinline__ void softmax_step(RowState& r, f32x4& v0, f32x4& v1) {
    const float lm = max8(v0, v1);
    if (__any(lm > r.m + 12.0f)) {
        const float tm = grp_max(lm); const bool need = tm > r.m + 12.0f;
        const float mn = need ? tm : r.m; const float f = need ? __builtin_amdgcn_exp2f(r.m - mn) : 1.0f; r.m = mn; r.l *= f;
#pragma unroll
        for (int dt = 0; dt < 4; ++dt) r.o[dt] = r.o[dt] * f; }
    v0 = v0 - r.m; v1 = v1 - r.m;
#pragma unroll
    for (int i = 0; i < 4; ++i) { v0[i] = __builtin_amdgcn_exp2f(v0[i]); v1[i] = __builtin_amdgcn_exp2f(v1[i]); }
    const f32x4 sv = v0 + v1; r.l += (sv[0] + sv[1]) + (sv[2] + sv[3]);
}
__device__ __forceinline__ void stats_step(float& m, float& l, const f32x4& v0, const f32x4& v1) {
    const float lm = max8(v0, v1);
    if (__any(lm > m + 12.0f)) { const float tm = grp_max(lm); const bool need = tm > m + 12.0f; const float mn = need ? tm : m; l *= need ? __builtin_amdgcn_exp2f(m - mn) : 1.0f; m = mn; }
    const f32x4 a = v0 - m, c = v1 - m; float ps = 0.f;
#pragma unroll
    for (int i = 0; i < 4; ++i) ps += __builtin_amdgcn_exp2f(a[i]) + __builtin_amdgcn_exp2f(c[i]);
    l += ps;
}
__device__ __forceinline__ void softmax_fast(RowState& r, const bf16x8 (&kf)[4], const bf16x8 (&qf)[2], float bsel, f32x4& v0, f32x4& v1) {
    qk_mma(kf, qf, v0, v1, bsel - r.m);
    const int im = imax8(v0, v1);
    if (__any(im > 0x41400000  )) {
        qk_mma(kf, qf, v0, v1, bsel);
        const float tm = grp_max(max8(v0, v1)); const bool need = tm > r.m + 12.0f;
        const float mn = need ? tm : r.m; const float f = need ? __builtin_amdgcn_exp2f(r.m - mn) : 1.0f; r.m = mn; r.l *= f;
#pragma unroll
        for (int dt = 0; dt < 4; ++dt) r.o[dt] = r.o[dt] * f;
        v0 = v0 - r.m; v1 = v1 - r.m; }
#pragma unroll
    for (int i = 0; i < 4; ++i) { v0[i] = __builtin_amdgcn_exp2f(v0[i]); v1[i] = __builtin_amdgcn_exp2f(v1[i]); }
    const f32x4 sv = v0 + v1; r.l += (sv[0] + sv[1]) + (sv[2] + sv[3]);
}
__device__ __forceinline__ void bias_general(f32x4& v0, f32x4& v1, int d0, int W, bool ok, const LAS float* lh) {
#pragma unroll
    for (int i = 0; i < 4; ++i) { const int da = d0 - i, db = d0 - 16 - i;
        v0[i] = (ok && da >= 0 && da < W) ? v0[i] + lh[da < 127 ? da : 127] : -INFINITY;
        v1[i] = (ok && db >= 0 && db < W) ? v1[i] + lh[db < 127 ? db : 127] : -INFINITY; }
}
__device__ __forceinline__ void bias_general2(f32x4& v0, f32x4& v1, int d0, int W, bool ok, const LAS float* lh) {
#pragma unroll
    for (int i = 0; i < 4; ++i) { const int da = d0 - i, db = d0 - 16 - i;
        const float ba = lh[min(max(da, 0), 127)], bb = lh[min(max(db, 0), 127)];
        v0[i] += (ok && da >= 0 && da < W) ? ba : -INFINITY;
        v1[i] += (ok && db >= 0 && db < W) ? bb : -INFINITY; }
}
__device__ __forceinline__ void build_lut2(Frame& F, LAS float* lut) {
    for (int i = F.tid; i < 16 * 128; i += NTHR) { const int h = i >> 7, d = i & 127; lut[i] = F.rel_tab[t5_bucket(d) * 16 + h] * LOG2E; }
    __syncthreads();
}
__device__ __forceinline__ void store_orow8(unsigned char* op, const f32x4 (&o)[4], float sc) {
#pragma unroll
    for (int dt = 0; dt < 4; ++dt) { const f32x4 x = o[dt] * sc; *(unsigned*)(op + 16 * dt) = pack_fp8x4(x[0], x[1], x[2], x[3]); }
}
__device__ __forceinline__ void store_orow(bf16* op, const f32x4 (&o)[4], float sc) {
#pragma unroll
    for (int dt = 0; dt < 4; ++dt) { const f32x4 x = o[dt] * sc; v2u w; w.x = cvt_pk_bf16(x[0], x[1]); w.y = cvt_pk_bf16(x[2], x[3]); *(v2u*)(op + 16 * dt) = w; }
}

__device__ __forceinline__ void p_swa2(Frame& F, int l) {
    LAS float* lut = (LAS float*)(F.lds + 98304);
    build_lut2(F, lut);
    LAS unsigned char* kt = F.lds; LAS unsigned char* vt = F.lds + 2 * KT_BYTES;
    const bf16* KS = wsb(F, WS_KV) + 6 * KVB; const bf16* VS = wsb(F, WS_KV) + 7 * KVB;
    const int lane = F.lane, kg = lane >> 4, rl = lane & 15, hh = rl & 3;
    const bool skew = (F.G == 256); const int nmine = !skew ? (NB * 2 * (S / 64) - (int)blockIdx.x + F.G - 1) / F.G : (F.vcu < 64 ? 2 : (F.vcu - 64 < 128 ? 5 : 4));
    for (int ii = 0; ii < nmine; ++ii) {
        const int it = !skew ? (int)blockIdx.x + ii * F.G : (F.vcu < 64 ? 896 + 2 * F.vcu + ii : (ii < 4 ? (F.vcu - 64) + 192 * ii : 768 + (F.vcu - 64)));
        const int b = it / (2 * (S / 64)), kvh = (it / (S / 64)) & 1, qb = it % (S / 64), s0 = qb * 64;
        const int head = kvh * 4 + hh; const LAS float* lh = lut + (8 + head) * 128;
        const bf16* kb = KS + ((size_t)(b * 2 + kvh) * S) * 64; const bf16* vb = VS + ((size_t)(b * 2 + kvh) * S) * 64;
        bf16x8 qf[2][2]; RowState rs[2]; int tl[2];
#pragma unroll
        for (int rt = 0; rt < 2; ++rt) { tl[rt] = s0 + 8 * F.wave + 4 * rt + (rl >> 2);
            load_qfrag(wsb(F, WS_QS) + ((size_t)b * S + tl[rt]) * 512 + head * 64, kg, qf[rt]);
            rs_init(rs[rt], F.sinks[l * 8 + head] * LOG2E, kg == 0 ? 1.0f : 0.f); }
        const int jt0 = qb >= 2 ? qb - 2 : 0, ntile = qb - jt0 + 1;
        KVRegs kr; kv_fetch(kr, kb, vb, jt0 * 64, F.tid);
        for (int ti = 0; ti < ntile; ++ti) {
            const int buf = ti & 1; kv_put(kr, kt + buf * KT_BYTES, vt + buf * KT_BYTES, F.tid);
            __syncthreads();
            if (ti + 1 < ntile) kv_fetch(kr, kb, vb, (jt0 + ti + 1) * 64, F.tid);
            const int kp0 = (jt0 + ti) * 64;
#pragma unroll 1
            for (int ks = 0; ks < 2; ++ks) { bf16x8 kf[4], vf[4]; load_kfrag(kt + buf * KT_BYTES, 32 * ks, lane, kf); load_vfrag(vt + buf * KT_BYTES, 32 * ks, lane, vf);
#pragma unroll
                for (int rt = 0; rt < 2; ++rt) { f32x4 v0, v1; qk_mma(kf, qf[rt], v0, v1);
                    bias_general2(v0, v1, tl[rt] - (kp0 + 32 * ks + 4 * kg), 128, true, lh);
                    softmax_step(rs[rt], v0, v1);
                    pv_mma(vf, v0, v1, rs[rt].o); } }
        }
#pragma unroll
        for (int rt = 0; rt < 2; ++rt) { if (MIX_FP8) store_orow8(F.ws + WS_ON + ((size_t)b * S + tl[rt]) * 1024 + 512 + head * 64 + 4 * kg, rs[rt].o, O8_SCALE / grp_sum(rs[rt].l));
            else store_orow(wsb(F, WS_OS) + ((size_t)b * S + tl[rt]) * 512 + head * 64 + 4 * kg, rs[rt].o, 1.0f / grp_sum(rs[rt].l)); }
        __syncthreads();
    }
}

constexpr int CONV_RUNS = NE * (32 * 16 + 16 * 16);
__device__ __forceinline__ void conv_addr(const Frame& F, int l, int R, int k8, const float*& src, size_t& ldn, unsigned char*& dst) {
    const int e = R / 768, r = R - e * 768; const size_t le = (size_t)l * NE + e;
    if (r < 512) { const int n64 = r >> 4, k64 = r & 15; ldn = 2048; src = F.w_up + (le * 1024 + k64 * 64 + 8 * k8) * 2048 + n64 * 64; dst = F.ws + WS_WUP + (le * 2048 + n64 * 64) * 1024 + k64 * 64 + 8 * k8; }
    else { const int q = r - 512, n64 = q >> 4, k64 = q & 15; ldn = 1024; src = F.w_down + (le * 1024 + k64 * 64 + 8 * k8) * 1024 + n64 * 64; dst = F.ws + WS_WDN + (le * 1024 + n64 * 64) * 1024 + k64 * 64 + 8 * k8; }
}
__device__ __forceinline__ void conv_tick(const Frame& F, int l, int lane, int gw, int NGW, int nsteps, int& cs, bool& pend, float (&cv)[8], LAS unsigned char* stg) {
    if (pend) { const int sp = cs - 1, k8 = sp & 7;
        v2u w; w.x = pack_fp8x4(cv[0] * W8_SCALE, cv[1] * W8_SCALE, cv[2] * W8_SCALE, cv[3] * W8_SCALE); w.y = pack_fp8x4(cv[4] * W8_SCALE, cv[5] * W8_SCALE, cv[6] * W8_SCALE, cv[7] * W8_SCALE);
        *(LAS v2u*)(stg + lane * 80 + k8 * 8) = w;
        if (k8 == 7) { const float* src; size_t ldn; unsigned char* dst; conv_addr(F, l, gw + (sp >> 3) * NGW, 0, src, ldn, dst);
#pragma unroll
            for (int i = 0; i < 4; ++i) { const int n = 16 * i + (lane >> 2); const v4u x = *(const LAS v4u*)(stg + n * 80 + (lane & 3) * 16); *(v4u*)(dst + (size_t)n * 1024 + (lane & 3) * 16) = x; } }
        pend = false; }
    if (cs < nsteps) { const float* src; size_t ldn; unsigned char* dst; conv_addr(F, l, gw + (cs >> 3) * NGW, cs & 7, src, ldn, dst);
#pragma unroll
        for (int i = 0; i < 8; ++i) cv[i] = src[(size_t)i * ldn + lane];
        pend = true; ++cs; }
}

__device__ __forceinline__ int next_bit(unsigned long long lo, unsigned long long hi, int j) {
    int k = j + 1;
    if (k < 64) { const unsigned long long m = lo >> k; if (m) return k + __builtin_ctzll(m); k = 64; }
    if (k < 128) { const unsigned long long m = hi >> (k - 64); if (m) return k + __builtin_ctzll(m); }
    return 128;
}
__device__ __forceinline__ void setbit128(unsigned long long& lo, unsigned long long& hi, int idx) { if (idx < 64) lo |= 1ull << idx; else hi |= 1ull << (idx - 64); }
__device__ __forceinline__ unsigned getbit128(unsigned long long lo, unsigned long long hi, int idx) { return (unsigned)(((idx < 64 ? lo : hi) >> (idx & 63)) & 1ull); }
__device__ __forceinline__ unsigned long long rfl64(unsigned lo, unsigned hi) { return (unsigned long long)(unsigned)__builtin_amdgcn_readfirstlane((int)lo) | ((unsigned long long)(unsigned)__builtin_amdgcn_readfirstlane((int)hi) << 32); }

__device__ __forceinline__ void p_nsa2(Frame& F, int l, int mode = 0) {
    LAS float* lut = (LAS float*)(F.lds + 98304);
    build_lut2(F, lut);
    LAS unsigned char* kt = F.lds; LAS unsigned char* vt = F.lds + 2 * KT_BYTES;
    LAS float* psl = (LAS float*)(F.lds + 4 * KT_BYTES);
    volatile LAS unsigned* selm = (volatile LAS unsigned*)(F.lds + 94208);
    volatile LAS unsigned* unim = selm + 256;
    const bf16* kvb = wsb(F, WS_KV);
    const int cgw = F.vcu * NWAVES + F.wave, cNGW = F.G * NWAVES; const int cnsteps = (BG_CONV && mode == 0) ? 8 * ((CONV_RUNS - cgw + cNGW - 1) / cNGW) : 0; int ccs = 0; bool cpend = false; float ccv[8];
    LAS unsigned char* const cstg = F.lds + (F.wave < 4 ? 73728 + F.wave * 5120 : 106496 + (F.wave - 4) * 5120);
    const bool fast = (F.G == 256);
    const int nit = fast ? 4 : (NB * 2 * 128 - (int)blockIdx.x + F.G - 1) / F.G;
    for (int ii = 0; ii < nit; ++ii) {
        int it;
        if (fast) { const int x = F.vcu >> 5, c = F.vcu & 31; const int qbx = ii == 0 ? c : ii == 1 ? 63 - c : ii == 2 ? 64 + c : 127 - c; it = x * 128 + qbx; }
        else it = blockIdx.x + ii * F.G;
        const int b = it >> 8, g = (it >> 7) & 1, qb = it & 127, s0 = qb * 64;
        const size_t bgS = (size_t)(b * 2 + g) * S * 64;
        int lane = F.tid & 63; asm volatile("" : "+v"(lane));
        const int kg = lane >> 4, rl = lane & 15, hh = rl & 3, head = g * 4 + hh;
        __syncthreads();
        if (F.tid < 260) selm[F.tid] = 0u;
        bf16x8 qf[2][2]; int tl[2], qi[2]; v2u fin[2][4];
#pragma unroll
        for (int rt = 0; rt < 2; ++rt) { qi[rt] = 8 * F.wave + 4 * rt + (rl >> 2); tl[rt] = s0 + qi[rt];
            load_qfrag(wsb(F, WS_QN) + ((size_t)b * S + tl[rt]) * 512 + head * 64, kg, qf[rt]);
#pragma unroll
            for (int dt = 0; dt < 4; ++dt) { fin[rt][dt].x = 0u; fin[rt][dt].y = 0u; } }
#define NSA_GATE(rt, br) sigmoidf_(bflo((unsigned)(wsb(F, WS_GN) + ((size_t)b * S + tl[rt]) * 32)[(br) * 8 + head]))
#define NSA_FIN_ADD(rt, coef) do { _Pragma("unroll") for (int dt = 0; dt < 4; ++dt) { const f32x4 x = rs[rt].o[dt] * (coef); \
            fin[rt][dt].x = cvt_pk_bf16(bflo(fin[rt][dt].x) + x[0], bfhi(fin[rt][dt].x) + x[1]); fin[rt][dt].y = cvt_pk_bf16(bflo(fin[rt][dt].y) + x[2], bfhi(fin[rt][dt].y) + x[3]); } } while (0)
        __syncthreads();
        if (mode != 2) {   const bf16* kc = wsb(F, WS_CMP) + (size_t)(b * 2 + g) * 512 * 64; const bf16* vc = kc + (size_t)NB * 2 * 512 * 64;
            const int tmax = s0 + 63, ncmax = tmax >= 31 ? min((tmax - 31) / 16 + 1, NCMP) : 0, nct = (ncmax + 63) >> 6;
            const int tw0 = s0 + 8 * F.wave, ncw = tw0 >= 31 ? min((tw0 - 31) / 16 + 1, NCMP) : 0;
            int ncl[2]; float cm[2], cl[2];
#pragma unroll
            for (int rt = 0; rt < 2; ++rt) { ncl[rt] = tl[rt] >= 31 ? min((tl[rt] - 31) / 16 + 1, NCMP) : 0; cm[rt] = M_INIT; cl[rt] = 0.f; }
#pragma unroll
            for (int pass = 0; pass < 2; ++pass) {
                RowState rs[2];
                if (pass == 1) {
#pragma unroll
                    for (int rt = 0; rt < 2; ++rt) { const float lt = grp_sum(cl[rt]); cl[rt] = lt > 0.f ? 1.0f / lt : 0.f; rs_init(rs[rt], 0.f, 0.f); } }
                if (nct > 0) {
                    KVRegs kr; kv_fetch(kr, kc, vc, 0, F.tid);
                    for (int ct = 0; ct < nct; ++ct) {
                        const int buf = ct & 1; kv_put(kr, kt + buf * KT_BYTES, vt + buf * KT_BYTES, F.tid);
                        __syncthreads();
                        if (ct + 1 < nct) kv_fetch(kr, kc, vc, (ct + 1) * 64, F.tid);
                        const bool full = (ct * 64 + 64 <= ncw);
#pragma unroll 1
                        for (int ks = 0; ks < 2; ++ks) { bf16x8 kf[4], vf[4]; load_kfrag(kt + buf * KT_BYTES, 32 * ks, lane, kf); if (pass == 1) load_vfrag(vt + buf * KT_BYTES, 32 * ks, lane, vf);
#pragma unroll
                            for (int rt = 0; rt < 2; ++rt) { f32x4 v0, v1; qk_mma(kf, qf[rt], v0, v1);
                                const int i0 = ct * 64 + 32 * ks + 4 * kg;
                                if (!full) {
#pragma unroll
                                    for (int i = 0; i < 4; ++i) { v0[i] = (i0 + i < ncl[rt]) ? v0[i] : -INFINITY; v1[i] = (i0 + 16 + i < ncl[rt]) ? v1[i] : -INFINITY; } }
                                if (pass == 0) stats_step(cm[rt], cl[rt], v0, v1);
                                else {
#pragma unroll
                                    for (int i = 0; i < 4; ++i) { v0[i] = __builtin_amdgcn_exp2f(v0[i] - cm[rt]) * cl[rt]; v1[i] = __builtin_amdgcn_exp2f(v1[i] - cm[rt]) * cl[rt]; }
                                    pv_mma(vf, v0, v1, rs[rt].o);
                                    const float a0s = quad_sum(v0[0]), a1s = quad_sum(v0[0] + 2.0f * (v0[1] + v0[2] + v0[3])), c0s = quad_sum(v1[0]), c1s = quad_sum(v1[0] + 2.0f * (v1[1] + v1[2] + v1[3]));
                                    if (hh == 0) { LAS _Float16* pr = (LAS _Float16*)psl + qi[rt] * 136; const int B0 = (i0 >> 2);
                                        pr[B0] = (_Float16)a0s; pr[64 * 136 + B0 + 1] = (_Float16)a1s; pr[B0 + 4] = (_Float16)c0s; pr[64 * 136 + B0 + 5] = (_Float16)c1s; }
                                } } }
                    }
                    __syncthreads();
                }
                if (pass == 1) {
#pragma unroll
                    for (int rt = 0; rt < 2; ++rt) { const float g0 = NSA_GATE(rt, 0); NSA_FIN_ADD(rt, g0); } }
            }
        }
        __syncthreads();
        if (mode != 2) {   int tz = threadIdx.x; asm volatile("" : "+v"(tz));
            const int q = tz >> 3, part = tz & 7; unsigned long long mlo = 0ull, mhi = 0ull;
            if (qb < 16) { mlo = (1ull << (qb + 1)) - 1ull; }
            else {
                float vals[16];
#pragma unroll
                for (int i = 0; i < 16; ++i) { const int j = part * 16 + i; const LAS _Float16* ph = (const LAS _Float16*)psl + q * 136 + j; vals[i] = (j >= 1 && j <= qb - 2) ? (float)ph[0] + (float)ph[64 * 136] : -1.0f; }
                mlo |= 1ull; setbit128(mlo, mhi, qb - 1); setbit128(mlo, mhi, qb);
                for (int r = 0; r < 13; ++r) { float bv = -1.0f; int bi = 1 << 20;
#pragma unroll
                    for (int i = 0; i < 16; ++i) { if (vals[i] > bv) { bv = vals[i]; bi = part * 16 + i; } }
#pragma unroll
                    for (int o = 0; o < 3; ++o) { const float ov = o == 0 ? dpp_x1(bv) : o == 1 ? dpp_x2(bv) : dpp_hm(bv); const int oi = o == 0 ? dpp_x1i(bi) : o == 1 ? dpp_x2i(bi) : dpp_hmi(bi); if (ov > bv || (ov == bv && oi < bi)) { bv = ov; bi = oi; } }
#pragma unroll
                    for (int i = 0; i < 16; ++i) if (part * 16 + i == bi) vals[i] = -2.0f;
                    setbit128(mlo, mhi, bi); }
            }
            if (part == 0) { selm[q * 4 + 0] = (unsigned)mlo; selm[q * 4 + 1] = (unsigned)(mlo >> 32); selm[q * 4 + 2] = (unsigned)mhi; selm[q * 4 + 3] = (unsigned)(mhi >> 32);
                atomicOr((unsigned*)&unim[0], (unsigned)mlo); atomicOr((unsigned*)&unim[1], (unsigned)(mlo >> 32)); atomicOr((unsigned*)&unim[2], (unsigned)mhi); atomicOr((unsigned*)&unim[3], (unsigned)(mhi >> 32)); }
        }
        __syncthreads();
        if (mode == 1) continue;
        if (mode != 2) {   unsigned long long rlo[2], rhi[2];
#pragma unroll
            for (int rt = 0; rt < 2; ++rt) { unsigned w0 = 0u, w1 = 0u, w2 = 0u, w3 = 0u; const int qb0 = 8 * F.wave + 4 * rt;
#pragma unroll
                for (int k = 0; k < 4; ++k) { w0 |= selm[(qb0 + k) * 4 + 0]; w1 |= selm[(qb0 + k) * 4 + 1]; w2 |= selm[(qb0 + k) * 4 + 2]; w3 |= selm[(qb0 + k) * 4 + 3]; }
                rlo[rt] = rfl64(w0, w1); rhi[rt] = rfl64(w2, w3); }
            const unsigned long long ulo = rfl64(unim[0], unim[1]), uhi = rfl64(unim[2], unim[3]);
            const LAS float* lh = lut + head * 128; const float bfar = lh[127];
            RowState rs[2]; rs_init(rs[0], M_INIT, 0.f); rs_init(rs[1], M_INIT, 0.f);
            const bf16* kb = kvb + 2 * KVB + bgS; const bf16* vb = kvb + 3 * KVB + bgS;
            LAS unsigned char* const kt2 = F.lds; LAS unsigned char* const vt2 = F.lds + 4 * KT_BYTES;
            int ja = next_bit(ulo, uhi, -1), jb = next_bit(ulo, uhi, ja), ti = 0; KVRegs kra, krb;
            if (ja <= qb) kv_fetch(kra, kb, vb, ja * 64, F.tid);
            if (jb <= qb) kv_fetch(krb, kb, vb, jb * 64, F.tid);
            while (ja <= qb) {
                const int p = (ti & 1) * 2;
                kv_put(kra, kt2 + p * KT_BYTES, vt2 + p * KT_BYTES, F.tid);
                if (jb <= qb) kv_put(krb, kt2 + (p + 1) * KT_BYTES, vt2 + (p + 1) * KT_BYTES, F.tid);
                __syncthreads();
                const int na = next_bit(ulo, uhi, jb), nb = next_bit(ulo, uhi, na);
                if (na <= qb) kv_fetch(kra, kb, vb, na * 64, F.tid);
                if (nb <= qb) kv_fetch(krb, kb, vb, nb * 64, F.tid);
#pragma unroll 1
                for (int h = 0; h < 2; ++h) {
                    const int j = h ? jb : ja; if (j > qb) break;
                    const LAS unsigned char* ktb = kt2 + (p + h) * KT_BYTES; const LAS unsigned char* vtb = vt2 + (p + h) * KT_BYTES;
                    const bool act0 = getbit128(rlo[0], rhi[0], j) != 0u, act1 = getbit128(rlo[1], rhi[1], j) != 0u;
                    if (BG_CONV && !(act0 && act1)) conv_tick(F, l, lane, cgw, cNGW, cnsteps, ccs, cpend, ccv, cstg);
                    if (act0 || act1) {
                        const bool far = (j + 3 <= qb);
                        bool sel[2]; float bsel[2];
#pragma unroll
                        for (int rt = 0; rt < 2; ++rt) { sel[rt] = ((selm[qi[rt] * 4 + (j >> 5)] >> (j & 31)) & 1u) != 0u; bsel[rt] = sel[rt] ? bfar : -INFINITY; }
#pragma unroll
                        for (int ks = 0; ks < 2; ++ks) { bf16x8 kf[4], vf[4]; load_kfrag(ktb, 32 * ks, lane, kf); load_vfrag(vtb, 32 * ks, lane, vf);
#pragma unroll
                            for (int rt = 0; rt < 2; ++rt) if (rt == 0 ? act0 : act1) { f32x4 v0, v1;
                                if (far) softmax_fast(rs[rt], kf, qf[rt], bsel[rt], v0, v1);
                                else { qk_mma(kf, qf[rt], v0, v1); bias_general2(v0, v1, tl[rt] - (j * 64 + 32 * ks + 4 * kg), 1 << 30, sel[rt], lh); softmax_step(rs[rt], v0, v1); }
                                pv_mma(vf, v0, v1, rs[rt].o); } }
                    }
                }
                ja = na; jb = nb; ++ti;
            }
#pragma unroll
            for (int rt = 0; rt < 2; ++rt) { const float lt = grp_sum(rs[rt].l); const float coef = lt > 0.f ? NSA_GATE(rt, 1) / lt : 0.f; NSA_FIN_ADD(rt, coef); }
        }
        __syncthreads();
        {   const LAS float* lh = lut + head * 128; const float bfar = lh[127];
            RowState rs[2]; rs_init(rs[0], M_INIT, 0.f); rs_init(rs[1], M_INIT, 0.f);
            const bf16* kb = kvb + 4 * KVB + bgS; const bf16* vb = kvb + 5 * KVB + bgS;
            const int jt0 = qb >= 8 ? qb - 8 : 0, ntile = qb - jt0 + 1;
            KVRegs kr; kv_fetch(kr, kb, vb, jt0 * 64, F.tid);
            for (int ti = 0; ti < ntile; ++ti) {
                const int buf = ti & 1; kv_put(kr, kt + buf * KT_BYTES, vt + buf * KT_BYTES, F.tid);
                __syncthreads();
                if (ti + 1 < ntile) kv_fetch(kr, kb, vb, (jt0 + ti + 1) * 64, F.tid);
                const int jt = jt0 + ti, kp0 = jt * 64;
                const bool mid = (jt + 3 <= qb) && (jt + 8 > qb);
#pragma unroll
                for (int ks = 0; ks < 2; ++ks) { bf16x8 kf[4], vf[4]; load_kfrag(kt + buf * KT_BYTES, 32 * ks, lane, kf); load_vfrag(vt + buf * KT_BYTES, 32 * ks, lane, vf);
#pragma unroll
                    for (int rt = 0; rt < 2; ++rt) { f32x4 v0, v1;
                        if (mid) softmax_fast(rs[rt], kf, qf[rt], bfar, v0, v1);
                        else { qk_mma(kf, qf[rt], v0, v1); bias_general2(v0, v1, tl[rt] - (kp0 + 32 * ks + 4 * kg), 512, true, lh); softmax_step(rs[rt], v0, v1); }
                        pv_mma(vf, v0, v1, rs[rt].o); } }
            }
#pragma unroll
            for (int rt = 0; rt < 2; ++rt) { const float lt = grp_sum(rs[rt].l); const float coef = lt > 0.f ? NSA_GATE(rt, 2) / lt : 0.f; NSA_FIN_ADD(rt, coef); }
        }
        if (mode == 0)
#pragma unroll
        for (int rt = 0; rt < 2; ++rt) {
            if (MIX_FP8) { unsigned char* op = F.ws + WS_ON + ((size_t)b * S + tl[rt]) * 1024 + head * 64 + 4 * kg;
#pragma unroll
                for (int dt = 0; dt < 4; ++dt) *(unsigned*)(op + 16 * dt) = pack_fp8x4(bflo(fin[rt][dt].x) * O8_SCALE, bfhi(fin[rt][dt].x) * O8_SCALE, bflo(fin[rt][dt].y) * O8_SCALE, bfhi(fin[rt][dt].y) * O8_SCALE); }
            else { bf16* op = wsb(F, WS_ON) + ((size_t)b * S + tl[rt]) * 512 + head * 64 + 4 * kg;
#pragma unroll
                for (int dt = 0; dt < 4; ++dt) *(v2u*)(op + 16 * dt) = fin[rt][dt]; } }
#undef NSA_GATE
#undef NSA_FIN_ADD
    }
    if (BG_CONV) { while (ccs < cnsteps || cpend) conv_tick(F, l, F.tid & 63, cgw, cNGW, cnsteps, ccs, cpend, ccv, cstg); }
}

constexpr int NPL = 10, NPH = 2 + NL * NPL;
struct Args { const float* in[21]; float* out; unsigned char* ws; int ph_lo, ph_hi; };
__global__ void __launch_bounds__(NTHR, 2) fwd(Args args) {
    extern __shared__ __attribute__((aligned(16))) unsigned char lds[];
    Frame F;
    F.lds = (LAS unsigned char*)lds; F.MISC = (volatile LAS unsigned*)(F.lds + MISC_OFF);
    F.tid = threadIdx.x; F.lane = F.tid & 63; F.wave = __builtin_amdgcn_readfirstlane(F.tid >> 6);
    F.G = gridDim.x; { const int bx = blockIdx.x; F.vcu = (F.G % 8 == 0) ? (bx % 8) * (F.G / 8) + bx / 8 : bx; }
    F.ws = args.ws; F.ctl = (unsigned*)(args.ws + WS_CTL); F.out = args.out;
    F.x = args.in[0]; F.c = args.in[1]; F.w_ada = args.in[2]; F.b_ada = args.in[3]; F.g_mix = args.in[4]; F.g_ffn = args.in[5]; F.g_final = args.in[6]; F.w_in = args.in[7];
    F.cmp_pos = args.in[8]; F.cmp_w1 = args.in[9]; F.cmp_w2 = args.in[10]; F.sinks = args.in[11]; F.rel_tab = args.in[12]; F.w_branch = args.in[13]; F.w_out = args.in[14];
    F.w_router = args.in[15]; F.b_router = args.in[16]; F.w_up = args.in[17]; F.b_up = args.in[18]; F.w_down = args.in[19]; F.b_down = args.in[20];
    for (int u = F.tid; u < (LDS_BYTES - MISC_OFF) / 4; u += NTHR) ((LAS unsigned*)(F.lds + MISC_OFF))[u] = 0u;
    __syncthreads();
    XcdBarrier bar; bar.bar = F.ctl + CW_BAR; bar.x = 0; bar.st = F.MISC;
#if !MK_PER_PHASE
    bar = xcd_barrier_post(F.ctl + CW_BAR, F.MISC);
#endif
    const int lo = args.ph_lo, hi = args.ph_hi;
#ifndef PH_EN
#define PH_EN 0xfff
#endif
#define EN(p) (((PH_EN) >> (p)) & 1)
#ifndef REP_MASK
#define REP_MASK 0x0
#endif
#ifndef NSA_PROBE_MODE
#define NSA_PROBE_MODE 0
#endif
#define REPS(p) (1 + (((REP_MASK) >> (p)) & 1))
#define IN(k) (lo <= (k) && (k) < hi)
#define SEAM(k) do { if (IN(k) && IN((k) + 1)) xcd_barrier(bar); } while (0)
#define PHASE_BEGIN() do { GAS unsigned char* _w = (GAS unsigned char*)args.ws; asm volatile("" : "+s"(_w)); F.ws = (unsigned char*)_w; F.ctl = (unsigned*)(F.ws + WS_CTL); int _t = threadIdx.x; asm volatile("" : "+v"(_t)); F.tid = _t; F.lane = _t & 63; F.wave = __builtin_amdgcn_readfirstlane(_t >> 6); } while (0)
    if (EN(0) && IN(0)) for (int rep = 0; rep < REPS(0); ++rep) { PHASE_BEGIN(); p0_prologue(F); }
    SEAM(0);
    if (EN(1) && IN(1)) for (int rep = 0; rep < REPS(1); ++rep) { PHASE_BEGIN(); p_norm0(F); }
    SEAM(1);
    for (int l = 0; l < NL; ++l) {
        const int pb = 2 + l * NPL;
        if (EN(2) && IN(pb + 0)) for (int rep = 0; rep < REPS(2); ++rep) { PHASE_BEGIN();
#if Z_FP8
            DenseSched<true> Sd{(const char*)(F.ws + WS_H8), (const char*)(F.ws + WS_WIN) + (size_t)l * NZ * 1024, NZ / 256, (T / 256) * (NZ / 256), F.G, F.vcu, 1024u, (size_t)256 * 1024, 1 << 30, 0};
            EpiZ E{F.ws}; pg8::gemm_phase<EpiZ, DenseSched<true>, true>(F.lds, 512, Sd, E, W8_E8M0, H8_E8M0); }
#else
            DenseSched<> Sd{(const char*)(F.ws + WS_H), (const char*)(F.ws + WS_WIN) + (size_t)l * NZ * 1024 * 2, NZ / 256, (T / 256) * (NZ / 256), F.G, F.vcu, 2048u, (size_t)256 * 1024 * 2, 1 << 30, 0};
            EpiZ E{F.ws}; pg8::gemm_phase(F.lds, 1024, Sd, E); }
#endif
        SEAM(pb + 0);
        if (EN(3) && IN(pb + 1)) for (int rep = 0; rep < REPS(3); ++rep) { PHASE_BEGIN();
            DenseSched<> Sd{(const char*)(F.ws + WS_KV), (const char*)(F.ws + WS_WC1) + (size_t)l * 2 * 512 * 1024 * 2, 2, 32 * 2, F.G, F.vcu, 2048u, (size_t)256 * 1024 * 2, 16, (size_t)512 * 1024 * 2};
            EpiF32 E{wsf(F, WS_UL), 512}; pg8::gemm_phase(F.lds, 1024, Sd, E);
            __syncthreads(); p_swa2(F, l); }
        SEAM(pb + 1);
        if (EN(4) && IN(pb + 2)) for (int rep = 0; rep < REPS(4); ++rep) { PHASE_BEGIN(); p_cmpfin(F, l); }
        SEAM(pb + 2);
        if (EN(5) && IN(pb + 3)) for (int rep = 0; rep < REPS(5); ++rep) { PHASE_BEGIN(); p_nsa2(F, l, rep ? NSA_PROBE_MODE : 0); }
        SEAM(pb + 3);
        if (EN(6) && IN(pb + 4)) for (int rep = 0; rep < REPS(6); ++rep) { PHASE_BEGIN();
#if MIX_FP8
            DenseSched<true> Sd{(const char*)(F.ws + WS_ON), (const char*)(F.ws + WS_WBR) + (size_t)l * 1024 * 1024, 4, (T / 256) * 4, F.G, F.vcu, 1024u, (size_t)256 * 1024, 1 << 30, 0};
            EpiMerge1 E{F.ws}; pg8::gemm_phase<EpiMerge1, DenseSched<true>, true>(F.lds, 512, Sd, E, MIX_E8M0, MIX_E8M0); }
#else
            MergeSched Sm{(const char*)(F.ws + WS_ON), (const char*)(F.ws + WS_WBR) + (size_t)l * 2 * 1024 * 512 * 2, F.G, F.vcu};
            EpiMerge E{F.ws}; pg8::gemm_phase(F.lds, 512, Sm, E); }
#endif
        SEAM(pb + 4);
        if (EN(7) && IN(pb + 5)) for (int rep = 0; rep < REPS(7); ++rep) { PHASE_BEGIN();
#if MIX_FP8
            DenseSched<true> Sd{(const char*)(F.ws + WS_MG), (const char*)(F.ws + WS_WOUT) + (size_t)l * 1024 * 1024, 4, (T / 256) * 4, F.G, F.vcu, 1024u, (size_t)256 * 1024, 1 << 30, 0};
#if RES_BF16
            EpiResidB E{l == 0 ? F.x : (const float*)nullptr, wsb(F, WS_XA), wsb(F, WS_XB), wsf(F, WS_MOD) + (size_t)l * NB * 6144 + 2 * 1024}; pg8::gemm_phase<EpiResidB, DenseSched<true>, true>(F.lds, 512, Sd, E, MIX_E8M0, MIX_E8M0); }
#else
            EpiResid E{l == 0 ? F.x : (const float*)wsf(F, WS_XA), wsf(F, WS_XB), wsf(F, WS_MOD) + (size_t)l * NB * 6144 + 2 * 1024}; pg8::gemm_phase<EpiResid, DenseSched<true>, true>(F.lds, 512, Sd, E, MIX_E8M0, MIX_E8M0); }
#endif
#else
            DenseSched<> Sd{(const char*)(F.ws + WS_MG), (const char*)(F.ws + WS_WOUT) + (size_t)l * 1024 * 1024 * 2, 4, (T / 256) * 4, F.G, F.vcu, 2048u, (size_t)256 * 1024 * 2, 1 << 30, 0};
            EpiResid E{l == 0 ? F.x : (const float*)wsf(F, WS_XA), wsf(F, WS_XB), wsf(F, WS_MOD) + (size_t)l * NB * 6144 + 2 * 1024}; pg8::gemm_phase(F.lds, 1024, Sd, E); }
#endif
        SEAM(pb + 5);
        if (EN(8) && IN(pb + 6)) for (int rep = 0; rep < REPS(8); ++rep) { PHASE_BEGIN(); p_router2(F, l); }
        SEAM(pb + 6);
        if (EN(9) && IN(pb + 7)) for (int rep = 0; rep < REPS(9); ++rep) { PHASE_BEGIN();
            build_tiles(F, l);
#if MOE_FP8_UP
            MoeSched<true> Sm{(const char*)(F.ws + WS_H8), (const char*)(F.ws + WS_WUP) + (size_t)l * NE * 2048 * 1024, wsi(F, WS_LIST), F.MISC, 8, F.G, F.vcu, (size_t)2048 * 1024, (size_t)256 * 1024, 1024u, true};
            EpiSwiglu<MOE_FP8_DN != 0> E{wsb(F, WS_HID), F.b_up + (size_t)l * NE * 2048, F.lds + MISC_OFF + MB_BIAS}; pg8::gemm_phase<EpiSwiglu<MOE_FP8_DN != 0>, MoeSched<true>, true>(F.lds, 512, Sm, E, W8_E8M0, H8_E8M0); }
#else
            MoeSched<true> Sm{(const char*)(F.ws + WS_H), (const char*)(F.ws + WS_WUP) + (size_t)l * NE * 2048 * 1024 * 2, wsi(F, WS_LIST), F.MISC, 8, F.G, F.vcu, (size_t)2048 * 1024 * 2, (size_t)256 * 1024 * 2, 2048u, true};
            EpiSwiglu<MOE_FP8_DN != 0> E{wsb(F, WS_HID), F.b_up + (size_t)l * NE * 2048, F.lds + MISC_OFF + MB_BIAS}; pg8::gemm_phase(F.lds, 1024, Sm, E); }
#endif
        SEAM(pb + 7);
        if (EN(10) && IN(pb + 8)) for (int rep = 0; rep < REPS(10); ++rep) { PHASE_BEGIN();
            build_tiles(F, l);
#if MOE_FP8_DN
            MoeSched<true> Sm{(const char*)(F.ws + WS_HID), (const char*)(F.ws + WS_WDN) + (size_t)l * NE * 1024 * 1024, wsi(F, WS_LIST), F.MISC, 4, F.G, F.vcu, (size_t)1024 * 1024, (size_t)256 * 1024, 1024u, false};
            EpiBias E{wsb(F, WS_EO), F.b_down + (size_t)l * NE * 1024, F.lds + MISC_OFF + MB_BIAS}; pg8::gemm_phase<EpiBias, MoeSched<true>, true>(F.lds, 512, Sm, E, W8_E8M0, HID8_E8M0); }
#else
            MoeSched<false> Sm{(const char*)(F.ws + WS_HID), (const char*)(F.ws + WS_WDN) + (size_t)l * NE * 1024 * 1024 * 2, wsi(F, WS_LIST), F.MISC, 4, F.G, F.vcu, (size_t)1024 * 1024 * 2, (size_t)256 * 1024 * 2, 2048u, false};
            EpiBias E{wsb(F, WS_EO), F.b_down + (size_t)l * NE * 1024, F.lds + MISC_OFF + MB_BIAS}; pg8::gemm_phase(F.lds, 1024, Sm, E); }
#endif
        SEAM(pb + 8);
        if (EN(11) && IN(pb + 9)) for (int rep = 0; rep < REPS(11); ++rep) { PHASE_BEGIN(); p_combine(F, l); }
        SEAM(pb + 9);
    }
#undef IN
#undef SEAM
}

extern "C" void kernel_launch(void* const* d_in, const int* in_sizes, int n_in, void* d_out, int out_size, void* d_ws, size_t ws_size, hipStream_t stream) {
    static int grid = 0;
    if (grid == 0) {
        if (n_in != 21 || out_size != T * D || ws_size < WS_END) { fprintf(stderr, "kernel_launch: unexpected problem (n_in %d, out %d, ws %zu < %zu)\n", n_in, out_size, ws_size, (size_t)WS_END); grid = -1; return; }
        int dev = 0, cus = 0, per_cu = 0;
        if (hipGetDevice(&dev) != hipSuccess || hipDeviceGetAttribute(&cus, hipDeviceAttributeMultiprocessorCount, dev) != hipSuccess) { grid = -1; return; }
        if (hipFuncSetAttribute((const void*)fwd, hipFuncAttributeMaxDynamicSharedMemorySize, LDS_BYTES) != hipSuccess) { fprintf(stderr, "kernel_launch: hipFuncSetAttribute failed\n"); grid = -1; return; }
        if (hipOccupancyMaxActiveBlocksPerMultiprocessor(&per_cu, (const void*)fwd, NTHR, LDS_BYTES) != hipSuccess || per_cu < 1) fprintf(stderr, "kernel_launch: occupancy query says %d\n", per_cu);
        (void)hipGetLastError();
        grid = cus;
    }
    if (grid < 0) return;
    if (hipMemsetAsync((char*)d_ws + WS_CTL, 0, CTL_BYTES, stream) != hipSuccess) return;
    Args a{};
    for (int i = 0; i < 21; ++i) a.in[i] = (const float*)d_in[i];
    a.out = (float*)d_out; a.ws = (unsigned char*)d_ws;
#if MK_PER_PHASE
    for (int ph = 0; ph < NPH; ++ph) { a.ph_lo = ph; a.ph_hi = ph + 1; hipLaunchKernelGGL(fwd, dim3(grid), dim3(NTHR), LDS_BYTES, stream, a); }
#else
    a.ph_lo = 0; a.ph_hi = NPH; hipLaunchKernelGGL(fwd, dim3(grid), dim3(NTHR), LDS_BYTES, stream, a);
#endif
}
```
